# Optimizing an MI355X kernel written in HIP

```python
import math
import jax, jax.numpy as jnp
from jax import lax
import numpy as np

D_MODEL = 1024
BATCH = 8
SEQ = 2048
DEPTH = 2

A_HEADS = 4
A_DH = 64
A_DV = 2 * A_DH
A_QW = A_HEADS * 2 * A_DH
A_VW = A_HEADS * A_DV
A_BLOCK = 128
R_HEADS = 8
R_N = 64
R_W = R_HEADS * R_N
R_LORA_W = 64
R_LORA_A = 64
R_LORA_G = 128
R_COLS = 3 * R_W + R_LORA_W + R_LORA_A + R_LORA_G
RWKV_GN_EPS = 64e-5
G_HEADS = 4
G_DK = 64
G_DV = 128
G_KW = G_HEADS * G_DK
G_VW = G_HEADS * G_DV
G_LORA = 16
G_TAU = 16.0
G_CHUNK = 64
G_COLS = 2 * G_KW + G_VW + G_LORA + G_VW
A_COLS = 2 * A_QW + A_VW
GATE_COLS = 3 * D_MODEL
N_IN = A_COLS + R_COLS + G_COLS + GATE_COLS
N_GROUPS = 4
EXP_PER_GROUP = 8
N_EXPERTS = N_GROUPS * EXP_PER_GROUP
TOP_K = 2
D_EXPERT = 512
MOE_BLOCK = 128
EPS = 1e-6

kernel_name = 'hybrid_diffattn_rwkv7_gla_hmoe_adaln'


def _split(t, widths):
    cuts = [int(i) for i in np.cumsum(widths)[:-1]]
    return jnp.split(t, cuts, axis=-1)


def rms_norm(x, g, eps=EPS):
    xf = x.astype(jnp.float32)
    y = xf * lax.rsqrt(jnp.mean(xf * xf, axis=-1, keepdims=True) + eps)
    return (y * g.astype(jnp.float32)).astype(x.dtype)


def group_norm(x, g, b, eps):
    xf = x.astype(jnp.float32)
    mu = jnp.mean(xf, axis=-1, keepdims=True)
    var = jnp.mean(jnp.square(xf - mu), axis=-1, keepdims=True)
    return (xf - mu) * lax.rsqrt(var + eps) * g.astype(jnp.float32) + b.astype(jnp.float32)


def token_shift(t):
    return jnp.pad(t, ((0, 0), (1, 0), (0, 0)))[:, :-1]


def diff_attention(q, k, v, qn_g, kn_g, lam_vecs, subln_g, lambda_init):
    B, S = q.shape[:2]
    q = rms_norm(q, qn_g) * (A_DH ** -0.5)
    k = rms_norm(k, kn_g)
    q = q.transpose(0, 2, 3, 1, 4)
    k = k.transpose(0, 2, 3, 1, 4)
    v = v.transpose(0, 2, 1, 3)
    lv = lam_vecs.astype(jnp.float32)
    lam = jnp.exp(jnp.sum(lv[0] * lv[1])) - jnp.exp(jnp.sum(lv[2] * lv[3])) + lambda_init
    slopes = jnp.asarray([2.0 ** (-8.0 * (i + 1) / A_HEADS) for i in range(A_HEADS)], jnp.float32)
    kpos = jnp.arange(S)

    def block(i):
        q_blk = lax.dynamic_slice_in_dim(q, i * A_BLOCK, A_BLOCK, axis=3)
        s = jnp.einsum('bhcqd,bhckd->bhcqk', q_blk, k).astype(jnp.float32)
        qpos = i * A_BLOCK + jnp.arange(A_BLOCK)
        dist = qpos[:, None] - kpos[None, :]
        s = s - (slopes[:, None, None] * dist.astype(jnp.float32))[None, :, None]
        s = jnp.where(dist >= 0, s, -jnp.inf)
        p = jax.nn.softmax(s, axis=-1)
        a = p[:, :, 0] - lam * p[:, :, 1]
        return jnp.einsum('bhqk,bhkd->bhqd', a.astype(v.dtype), v)

    o = lax.map(block, jnp.arange(S // A_BLOCK))
    o = o.transpose(1, 0, 3, 2, 4).reshape(B, S, A_HEADS, A_DV)
    o = rms_norm(o, subln_g) * (1.0 - lambda_init)
    return o.reshape(B, S, A_VW)


def rwkv7_mix(slab, mu, w_up, w0, a_up, a0, g_up, k_k, k_a, r_k, lnx_g, lnx_b):
    B, S = slab.shape[:2]
    f32 = jnp.float32
    slab = slab + (token_shift(slab) - slab) * mu
    r, k, v, wd, ad, gd = _split(slab, [R_W, R_W, R_W, R_LORA_W, R_LORA_A, R_LORA_G])
    w = -jax.nn.softplus(-(w0 + jnp.tanh(wd) @ w_up)) - 0.5
    decay = jnp.exp(-jnp.exp(w.astype(f32)))
    a = jax.nn.sigmoid(a0 + ad @ a_up)
    g = jax.nn.sigmoid(gd) @ g_up
    hs = lambda t: t.reshape(B, S, R_HEADS, R_N).astype(f32)
    r, k, v, decay, a = hs(r), hs(k), hs(v), hs(decay), hs(a)
    kk = k * k_k.reshape(R_HEADS, R_N).astype(f32)
    kk = kk / jnp.maximum(jnp.sqrt(jnp.sum(kk * kk, axis=-1, keepdims=True)), 1e-12)
    k = k * (1.0 + (a - 1.0) * k_a.reshape(R_HEADS, R_N).astype(f32))

    def step(state, inp):
        r_t, w_t, k_t, v_t, kk_t, a_t = inp
        sa = jnp.einsum('bhvk,bhk->bhv', state, -kk_t)
        state = (state * w_t[:, :, None, :] + sa[..., None] * (kk_t * a_t)[:, :, None, :]
                 + v_t[..., None] * k_t[:, :, None, :])
        return state, jnp.einsum('bhvk,bhk->bhv', state, r_t)

    xs = tuple(t.swapaxes(0, 1) for t in (r, decay, k, v, kk, a))
    s0 = jnp.zeros((B, R_HEADS, R_N, R_N), f32)
    _, y = lax.scan(step, s0, xs)
    y = y.swapaxes(0, 1)
    y = group_norm(y, lnx_g.reshape(R_HEADS, R_N), lnx_b.reshape(R_HEADS, R_N), RWKV_GN_EPS)
    bonus = jnp.sum(r * k * r_k.astype(f32), axis=-1, keepdims=True) * v
    out = (y + bonus) * g.reshape(B, S, R_HEADS, R_N).astype(f32)
    return out.reshape(B, S, R_W).astype(slab.dtype)


def gla_mix(q, k, v, log_alpha, gate, norm_g):
    B, S = q.shape[:2]
    nc = S // G_CHUNK
    f32 = jnp.float32

    def chunks(t, d):
        return t.reshape(B, nc, G_CHUNK, G_HEADS, d).transpose(1, 0, 3, 2, 4).astype(f32)

    qc = chunks(q, G_DK) * (G_DK ** -0.5)
    kc, vc, lc = chunks(k, G_DK), chunks(v, G_DV), chunks(log_alpha, G_DK)
    causal = jnp.tril(jnp.ones((G_CHUNK, G_CHUNK), dtype=bool))[:, :, None]

    def step(state, inp):
        q_, k_, v_, l_ = inp
        b = jnp.cumsum(l_, axis=2)
        o_inter = jnp.einsum('bhid,bhde->bhie', q_ * jnp.exp(b), state)
        diff = b[:, :, :, None, :] - b[:, :, None, :, :]
        dec = jnp.exp(jnp.where(causal, diff, -jnp.inf))
        scores = jnp.einsum('bhid,bhjd,bhijd->bhij', q_, k_, dec)
        o_intra = jnp.einsum('bhij,bhje->bhie', scores, v_)
        b_last = b[:, :, -1:, :]
        state = (state * jnp.exp(b_last)[:, :, 0, :, None]
                 + jnp.einsum('bhjd,bhje->bhde', k_ * jnp.exp(b_last - b), v_))
        return state, o_inter + o_intra

    s0 = jnp.zeros((B, G_HEADS, G_DK, G_DV), f32)
    _, o = lax.scan(step, s0, (qc, kc, vc, lc))
    o = o.transpose(1, 0, 3, 2, 4).reshape(B, S, G_HEADS, G_DV)
    o = rms_norm(o, norm_g) * jax.nn.silu(gate.astype(f32))
    return o.reshape(B, S, G_VW).astype(q.dtype)


def hier_moe(h, rg_w, rg_b, re_w, re_b, w_gate, w_up, w_down):
    B, S, D = h.shape
    T = B * S
    A = T * TOP_K
    xt = h.reshape(T, D)
    g_logits = (xt @ rg_w + rg_b).astype(jnp.float32)
    grp = jnp.argmax(g_logits, axis=-1)
    g_prob = jnp.take_along_axis(jax.nn.softmax(g_logits, axis=-1), grp[:, None], axis=1)
    e_logits = (xt @ re_w + re_b).astype(jnp.float32).reshape(T, N_GROUPS, EXP_PER_GROUP)
    e_in = jnp.take_along_axis(e_logits, grp[:, None, None], axis=1)[:, 0]
    top_v, top_i = lax.top_k(e_in, TOP_K)
    w_tok = g_prob * jax.nn.softmax(top_v, axis=-1)
    eid = (grp[:, None] * EXP_PER_GROUP + top_i).reshape(-1).astype(jnp.int32)
    tok = jnp.repeat(jnp.arange(T, dtype=jnp.int32), TOP_K)
    wts = w_tok.reshape(-1)
    order = jnp.argsort(eid)
    eid_s, tok_s, w_s = eid[order], tok[order], wts[order]
    counts = jax.ops.segment_sum(jnp.ones_like(eid), eid, num_segments=N_EXPERTS)
    padded = (counts + MOE_BLOCK - 1) // MOE_BLOCK * MOE_BLOCK
    pad_end = jnp.cumsum(padded)
    pad_start = pad_end - padded
    start = jnp.cumsum(counts) - counts
    dest = pad_start[eid_s] + jnp.arange(A, dtype=jnp.int32) - start[eid_s]
    n_blocks = -(-A // MOE_BLOCK) + N_EXPERTS
    R = n_blocks * MOE_BLOCK
    row_tok = jnp.zeros((R,), jnp.int32).at[dest].set(tok_s)
    blk_exp = jnp.minimum(jnp.searchsorted(pad_end, jnp.arange(n_blocks) * MOE_BLOCK, side='right'),
                          N_EXPERTS - 1)
    xin = xt[row_tok].reshape(n_blocks, MOE_BLOCK, D)

    def run(args):
        xb, e = args
        hid = jax.nn.silu(xb @ w_gate[e]) * (xb @ w_up[e])
        return hid @ w_down[e]

    y = lax.map(run, (xin, blk_exp)).reshape(R, D)
    out = jnp.zeros((T, D), h.dtype).at[tok_s].add(y[dest] * w_s[:, None].astype(h.dtype))
    return out.reshape(B, S, D)


def setup_inputs(seed: int = 0) -> dict:
    key = jax.random.key(seed)
    ks = iter(jax.random.split(key, 64))
    L, D = DEPTH, D_MODEL
    nrm = lambda shape, s: jax.random.normal(next(ks), shape, jnp.float32) * s
    ones_n = lambda shape: 1.0 + nrm(shape, 0.02)
    ada_b = nrm((L, 6 * D), 0.05)
    ada_b = ada_b.at[:, 2 * D:3 * D].add(0.5).at[:, 5 * D:6 * D].add(0.5)
    return {
        'x': nrm((BATCH, SEQ, D), 1.0),
        'c': nrm((BATCH, D), 1.0),
        'ada_w': nrm((L, D, 6 * D), 0.2 * D ** -0.5),
        'ada_b': ada_b,
        'norm1_g': ones_n((L, D)),
        'norm2_g': ones_n((L, D)),
        'w_in': nrm((L, D, N_IN), D ** -0.5),
        'attn_qn_g': ones_n((L, A_DH)),
        'attn_kn_g': ones_n((L, A_DH)),
        'attn_lambda': nrm((L, 4, A_DH), 0.1),
        'attn_subln_g': ones_n((L, A_DV)),
        'rwkv_mu': jax.random.uniform(next(ks), (L, R_COLS), jnp.float32),
        'rwkv_w_up': nrm((L, R_LORA_W, R_W), 0.1 * R_LORA_W ** -0.5),
        'rwkv_w0': jax.random.uniform(next(ks), (L, R_W), jnp.float32, -6.5, -1.5),
        'rwkv_a_up': nrm((L, R_LORA_A, R_W), R_LORA_A ** -0.5),
        'rwkv_a0': nrm((L, R_W), 0.1),
        'rwkv_g_up': nrm((L, R_LORA_G, R_W), R_LORA_G ** -0.5),
        'rwkv_k_k': 0.85 + nrm((L, R_W), 0.05),
        'rwkv_k_a': 1.0 + nrm((L, R_W), 0.05),
        'rwkv_r_k': nrm((L, R_HEADS, R_N), 0.1),
        'rwkv_lnx_g': ones_n((L, R_W)),
        'rwkv_lnx_b': nrm((L, R_W), 0.02),
        'gla_alpha_up': nrm((L, G_LORA, G_KW), G_LORA ** -0.5),
        'gla_alpha_b': 1.0 + nrm((L, G_KW), 0.5),
        'gla_norm_g': ones_n((L, G_DV)),
        'proj_attn': nrm((L, A_VW, D), A_VW ** -0.5),
        'proj_rwkv': nrm((L, R_W, D), R_W ** -0.5),
        'proj_gla': nrm((L, G_VW, D), G_VW ** -0.5),
        'w_out': nrm((L, D, D), D ** -0.5),
        'router_grp_w': nrm((L, D, N_GROUPS), D ** -0.5),
        'router_grp_b': nrm((L, N_GROUPS), 0.01),
        'router_exp_w': nrm((L, D, N_EXPERTS), D ** -0.5),
        'router_exp_b': nrm((L, N_EXPERTS), 0.01),
        'exp_w_gate': nrm((L, N_EXPERTS, D, D_EXPERT), D ** -0.5),
        'exp_w_up': nrm((L, N_EXPERTS, D, D_EXPERT), D ** -0.5),
        'exp_w_down': nrm((L, N_EXPERTS, D_EXPERT, D), D_EXPERT ** -0.5),
    }


def reference(x, c, ada_w, ada_b, norm1_g, norm2_g, w_in, attn_qn_g, attn_kn_g, attn_lambda,
              attn_subln_g, rwkv_mu, rwkv_w_up, rwkv_w0, rwkv_a_up, rwkv_a0, rwkv_g_up, rwkv_k_k,
              rwkv_k_a, rwkv_r_k, rwkv_lnx_g, rwkv_lnx_b, gla_alpha_up, gla_alpha_b, gla_norm_g,
              proj_attn, proj_rwkv, proj_gla, w_out, router_grp_w, router_grp_b, router_exp_w,
              router_exp_b, exp_w_gate, exp_w_up, exp_w_down):
    B, S, D = x.shape
    c_act = jax.nn.silu(c)
    for l in range(DEPTH):
        lambda_init = 0.8 - 0.6 * math.exp(-0.3 * l)
        mod = (c_act @ ada_w[l] + ada_b[l])[:, None, :]
        sh1, sc1, gt1, sh2, sc2, gt2 = jnp.split(mod, 6, axis=-1)
        h = rms_norm(x, norm1_g[l]) * (1.0 + sc1) + sh1
        p = h @ w_in[l]
        p_attn, p_rwkv, p_gla, p_gate = _split(p, [A_COLS, R_COLS, G_COLS, GATE_COLS])
        aq, ak, av = _split(p_attn, [A_QW, A_QW, A_VW])
        o_a = diff_attention(aq.reshape(B, S, A_HEADS, 2, A_DH), ak.reshape(B, S, A_HEADS, 2, A_DH),
                             av.reshape(B, S, A_HEADS, A_DV), attn_qn_g[l], attn_kn_g[l],
                             attn_lambda[l], attn_subln_g[l], lambda_init)
        o_r = rwkv7_mix(p_rwkv, rwkv_mu[l], rwkv_w_up[l], rwkv_w0[l], rwkv_a_up[l], rwkv_a0[l],
                        rwkv_g_up[l], rwkv_k_k[l], rwkv_k_a[l], rwkv_r_k[l], rwkv_lnx_g[l],
                        rwkv_lnx_b[l])
        gq, gk, gv, gad, ggate = _split(p_gla, [G_KW, G_KW, G_VW, G_LORA, G_VW])
        log_alpha = jax.nn.log_sigmoid((gad @ gla_alpha_up[l] + gla_alpha_b[l]).astype(jnp.float32)) / G_TAU
        o_g = gla_mix(gq.reshape(B, S, G_HEADS, G_DK), gk.reshape(B, S, G_HEADS, G_DK),
                      gv.reshape(B, S, G_HEADS, G_DV), log_alpha.reshape(B, S, G_HEADS, G_DK),
                      ggate.reshape(B, S, G_HEADS, G_DV), gla_norm_g[l])
        g_a, g_r, g_g = jnp.split(p_gate, 3, axis=-1)
        merged = (jax.nn.sigmoid(g_a) * (o_a @ proj_attn[l])
                  + jax.nn.sigmoid(g_r) * (o_r @ proj_rwkv[l])
                  + jax.nn.sigmoid(g_g) * (o_g @ proj_gla[l]))
        x = x + gt1 * (merged @ w_out[l])
        h2 = rms_norm(x, norm2_g[l]) * (1.0 + sc2) + sh2
        x = x + gt2 * hier_moe(h2, router_grp_w[l], router_grp_b[l], router_exp_w[l], router_exp_b[l],
                               exp_w_gate[l], exp_w_up[l], exp_w_down[l])
    return x
```

```cpp
#include <hip/hip_runtime.h>
#include <cstdio>
#include <cstdint>

#define LAS __attribute__((address_space(3)))
typedef unsigned short bf16_t;
typedef short bf16x8 __attribute__((ext_vector_type(8)));
typedef float f32x4 __attribute__((ext_vector_type(4)));
typedef float f32x16 __attribute__((ext_vector_type(16)));
typedef unsigned u32x4 __attribute__((ext_vector_type(4)));
typedef unsigned u32x2 __attribute__((ext_vector_type(2)));

constexpr int T_ = 16384, D_ = 1024, S_ = 2048, NB_ = 8, NP_ = 8192, NIN_ = 7952;
constexpr int ECAP = 16384;
constexpr int NWAVES = 8, NTHR = 512;
constexpr int LDS_BYTES = 163840, LDS_CTL = LDS_BYTES - 256, LDS_SCHED = 131072;

constexpr size_t MiB = 1u << 20;
constexpr size_t WS_CTL = 0, CTL_BYTES = 128 * 1024;
constexpr size_t WS_MOD = 1 * MiB, WS_LW = WS_MOD + 512 * 1024;
constexpr size_t WS_WIN = 2 * MiB, WS_WPROJ = 34 * MiB, WS_WOUT = 40 * MiB;
constexpr size_t WS_H = 44 * MiB, WS_OA = 76 * MiB, WS_OR = 92 * MiB, WS_OG = 108 * MiB, WS_VT = 124 * MiB;
constexpr size_t WS_RR = 140 * MiB, WS_RK = 156 * MiB, WS_RV = 172 * MiB, WS_RKK = 188 * MiB, WS_RBB = 204 * MiB, WS_RG = 220 * MiB, WS_RLD = 236 * MiB, WS_RBON = 268 * MiB;
constexpr size_t WS_LA = 270 * MiB, WS_P = 286 * MiB;
constexpr size_t WS_QH = WS_P, WS_KH = WS_P + 16 * MiB, WS_AV = WS_P + 32 * MiB, WS_RWS = WS_P + 48 * MiB, WS_GQ = WS_P + 104 * MiB, WS_GK = WS_P + 112 * MiB, WS_GV = WS_P + 120 * MiB, WS_GG = WS_P + 136 * MiB,
                 WS_GATES = WS_P + 152 * MiB, WS_GAD = WS_P + 248 * MiB;
constexpr size_t WS_RC = WS_RBON + 1 * MiB;
constexpr size_t WS_RY = WS_RWS;
constexpr size_t WS_WGU = WS_P, WS_WD = WS_P + 64 * MiB, WS_HID = WS_P + 96 * MiB, WS_YS = WS_P + 136 * MiB, WS_LIST = WS_P + 200 * MiB, WS_WL = WS_P + 202 * MiB;
constexpr size_t WS_END = WS_P + 256 * MiB;
constexpr int CW_BAR = 4096, CW_CNT = 16384;

__device__ __forceinline__ float bf2f(bf16_t v) { return __uint_as_float(((unsigned)v) << 16); }
__device__ __forceinline__ bf16_t f2bf(float f) { return __builtin_bit_cast(unsigned short, (__bf16)f); }
__device__ __forceinline__ unsigned pk2(float lo, float hi) { typedef __bf16 bf2 __attribute__((ext_vector_type(2))); bf2 v; v[0] = (__bf16)lo; v[1] = (__bf16)hi; return __builtin_bit_cast(unsigned, v); }
__device__ __forceinline__ float lo16(unsigned u) { return __uint_as_float(u << 16); }
__device__ __forceinline__ float hi16(unsigned u) { return __uint_as_float(u & 0xffff0000u); }
template <int CTRL> __device__ __forceinline__ float dppf(float v) { return __int_as_float(__builtin_amdgcn_mov_dpp(__float_as_int(v), CTRL, 0xF, 0xF, true)); }
__device__ __forceinline__ float sum8(float v) { v += dppf<0xB1>(v); v += dppf<0x4E>(v); v += dppf<0x141>(v); return v; }
__device__ __forceinline__ float sum16(float v) { v = sum8(v); v += dppf<0x140>(v); return v; }
__device__ __forceinline__ float wave_sum(float v) {
    v = sum16(v);
    const int i = __float_as_int(v);
    return (__int_as_float(__builtin_amdgcn_readlane(i, 0)) + __int_as_float(__builtin_amdgcn_readlane(i, 16))) + (__int_as_float(__builtin_amdgcn_readlane(i, 32)) + __int_as_float(__builtin_amdgcn_readlane(i, 48)));
}
__device__ __forceinline__ float xor32(float v, int lane) { return __int_as_float(__builtin_amdgcn_ds_bpermute((lane ^ 32) << 2, __float_as_int(v))); }
__device__ __forceinline__ float sigmoidf_(float x) { return 1.0f / (1.0f + __expf(-x)); }
__device__ __forceinline__ float siluf_(float x) { return x / (1.0f + __expf(-x)); }
__device__ __forceinline__ float softplusf_(float z) { return fmaxf(z, 0.f) + log1pf(__expf(-fabsf(z))); }
__device__ __forceinline__ int crow(int reg, int hh) { return (reg & 3) + 8 * (reg >> 2) + 4 * hh; }
#define MFMA32(a, b, c) __builtin_amdgcn_mfma_f32_32x32x16_bf16((a), (b), (c), 0, 0, 0)

#define XB_TMO      128
#define XB_XCNT(j)  (256  + 64 * (j))
#define XB_XSUB(j)  (1280 + 64 * (j))
#define XB_XGEN(j)  (2304 + 64 * (j))
#define XB_TOP      3328
#define XB_TOPGEN   3392
#define XCD_BAR_WORDS 3456
#define XB_SPIN_CAP (1u << 18)

__device__ __forceinline__ unsigned xb_ld(unsigned* p)              { return __hip_atomic_load(p, __ATOMIC_RELAXED, __HIP_MEMORY_SCOPE_AGENT); }
__device__ __forceinline__ unsigned xb_add(unsigned* p, unsigned v) { return __hip_atomic_fetch_add(p, v, __ATOMIC_RELAXED, __HIP_MEMORY_SCOPE_AGENT); }
__device__ __forceinline__ unsigned xb_xcc_id() { return (unsigned)__builtin_amdgcn_s_getreg((3 << 11) | 20) & 0xFu; }
#define XB_SPIN(cond, bar) do { unsigned _sp = 0; while (cond) { __builtin_amdgcn_s_sleep(1); \
    if ((++_sp & 255u) == 0u) { if (xb_ld(&(bar)[XB_TMO])) break; if (_sp > XB_SPIN_CAP) { atomicAdd(&(bar)[XB_TMO], 1u); break; } } } } while (0)

struct XcdBarrier { unsigned* bar; unsigned x; volatile LAS unsigned* st; };

__device__ __forceinline__ XcdBarrier xcd_barrier_post(unsigned* bar, volatile LAS unsigned* st) {
    XcdBarrier b; b.bar = bar; b.x = xb_xcc_id(); b.st = st;
    if (threadIdx.x == 0) (void)xb_add(&bar[XB_XCNT(b.x)], 1u);
    return b;
}
__device__ __forceinline__ void xcd_barrier_complete(unsigned* bar, unsigned x, unsigned& nloc, unsigned& nx) {
    const unsigned G = gridDim.x * gridDim.y * gridDim.z;
    unsigned sum, cnt, mine, sp = 0u;
    for (;;) {
        sum = 0u; cnt = 0u; mine = 0u;
#pragma unroll 1
        for (unsigned j = 0; j < 16; ++j) { const unsigned c = xb_ld(&bar[XB_XCNT(j)]); sum += c; cnt += (c > 0u) ? 1u : 0u; mine = (j == x) ? c : mine; }
        if (sum == G) break;
        __builtin_amdgcn_s_sleep(1);
        if ((++sp & 255u) == 0u) { if (xb_ld(&bar[XB_TMO])) break; if (sp > XB_SPIN_CAP) { atomicAdd(&bar[XB_TMO], 1u); break; } }
    }
    nloc = mine > 0u ? mine : 1u; nx = cnt > 0u ? cnt : 1u;
}
__device__ __forceinline__ void xcd_barrier(const XcdBarrier& b) {
    asm volatile("s_waitcnt vmcnt(0)" ::: "memory");
    __syncthreads();
    if (threadIdx.x == 0) {
        unsigned* bar = b.bar;
        __builtin_amdgcn_s_waitcnt(0);
        unsigned nloc = b.st[0], nx = b.st[1];
        if (nloc == 0u) { xcd_barrier_complete(bar, b.x, nloc, nx); b.st[0] = nloc; b.st[1] = nx; }
        const unsigned old = xb_add(&bar[XB_XSUB(b.x)], 1u);
        const unsigned gen = old / nloc;
        if (old + 1u == (gen + 1u) * nloc) {
            __builtin_amdgcn_fence(__ATOMIC_RELEASE, "agent");
            asm volatile("s_waitcnt vmcnt(0)" ::: "memory");
            const unsigned og = xb_add(&bar[XB_TOP], 1u);
            const unsigned tg = og / nx;
            if (og + 1u == (tg + 1u) * nx) xb_add(&bar[XB_TOPGEN], 1u);
            else XB_SPIN(xb_ld(&bar[XB_TOPGEN]) == tg, bar);
            __builtin_amdgcn_fence(__ATOMIC_ACQUIRE, "agent");
            xb_add(&bar[XB_XGEN(b.x)], 1u);
            asm volatile("s_waitcnt vmcnt(0)" ::: "memory");
        } else {
            XB_SPIN(xb_ld(&bar[XB_XGEN(b.x)]) == gen, bar);
            __builtin_amdgcn_fence(__ATOMIC_ACQUIRE, "agent");
            asm volatile("s_waitcnt vmcnt(0)" ::: "memory");
        }
    }
    __syncthreads();
}

namespace pg8 {
constexpr int BM = 256, BK = 64, HALF = 128, HTB = HALF * BK * 2, STAGE_BYTES = 8 * HTB, NXCD = 8, WGM = 8;
__host__ __device__ __forceinline__ int lds_byte(int r, int c) { const int st = (r >> 4) * 2 + (c >> 5), rr = r & 15, cc = c & 31, ob = rr * 64 + cc * 2; return st * 1024 + (ob ^ (((ob >> 9) & 1) << 5)); }
__host__ __device__ __forceinline__ void stage_rc(int b, int& R, int& C) { const int st = b / 1024, sb = b % 1024, swz = sb ^ (((sb >> 9) & 1) << 5); R = (st >> 1) * 16 + swz / 64; C = (st & 1) * 32 + (swz % 64) / 2; }
__host__ __device__ __forceinline__ int perm32(int rho) { const int n = rho >> 4, i = rho & 15; return 8 * (i >> 2) + 4 * n + (i & 3); }

struct Unit { const char* A; const char* B; const int* ridx; const float* wl; int nrows; int r0, c0, aux; };

template <class Epi, class Sched, bool GATHER>
__device__ __forceinline__ void gemm_phase(LAS unsigned char* lds, const int tid_in, const int K, const unsigned lda, const unsigned ldb, const Sched& S, const Epi& E) {
    const int tid = tid_in, wid = __builtin_amdgcn_readfirstlane(tid >> 6), lane = tid & 63, wr = wid >> 2, wc = wid & 3, fr = lane & 15, fq = lane >> 4;
    const int nt = K / BK;
    int sR[2], sC[2];
    unsigned voffA[2], voffB[2], cvA[2][2], nvA[2][2];
#pragma unroll
    for (int i = 0; i < 2; ++i) { int R, C; stage_rc(tid * 16 + i * 8192, R, C); sR[i] = R; sC[i] = C; const int Rb = Epi::PERM ? ((R & ~31) + perm32(R & 31)) : R;
        voffA[i] = (unsigned)R * lda + (unsigned)C * 2u; voffB[i] = (unsigned)Rb * ldb + (unsigned)C * 2u;
#pragma unroll
        for (int h = 0; h < 2; ++h) { cvA[h][i] = 0u; nvA[h][i] = 0u; } }
    const size_t kstep = (size_t)(BK * 2);
    const size_t hstepA = (size_t)HALF * lda, hstepB = (size_t)HALF * ldb;
    const unsigned ldsw = (unsigned)wid * 1024u;
    const int aoff = lds_byte(wr * 64 + fr, fq * 8), boff = lds_byte(wc * 32 + fr, fq * 8);
#define PG8_SA(b, h) (((b) * 2 + (h)) * HTB)
#define PG8_SB(b, h) ((4 + (b) * 2 + (h)) * HTB)
#define PG8_STG(bufoff, gbase, o0, o1) do { \
        __builtin_amdgcn_global_load_lds((const unsigned*)((const char*)(gbase) + (o0)), (LAS unsigned*)(lds + (bufoff) + ldsw), 16, 0, 0); \
        __builtin_amdgcn_global_load_lds((const unsigned*)((const char*)(gbase) + (o1)), (LAS unsigned*)(lds + (bufoff) + ldsw + 8192), 16, 0, 0); } while (0)
#define PG8_STGA(bufoff, gbase, h, NXT) do { if (GATHER) { const unsigned o0_ = (NXT) ? nvA[h][0] : cvA[h][0], o1_ = (NXT) ? nvA[h][1] : cvA[h][1]; PG8_STG(bufoff, gbase, o0_, o1_); } \
        else { PG8_STG(bufoff, (gbase) + (h) * hstepA, voffA[0], voffA[1]); } } while (0)
#define PG8_STGB(bufoff, gbase, h) PG8_STG(bufoff, (gbase) + (h) * hstepB, voffB[0], voffB[1])
#define PG8_LDA(dst, b, h) do { _Pragma("unroll") for (int m = 0; m < 4; ++m) _Pragma("unroll") for (int k = 0; k < 2; ++k) dst[m][k] = *(const LAS bf16x8*)(lds + PG8_SA(b, h) + aoff + m * 2048 + k * 1024); } while (0)
#define PG8_LDB(dst, b, h) do { _Pragma("unroll") for (int n = 0; n < 2; ++n) _Pragma("unroll") for (int k = 0; k < 2; ++k) dst[n][k] = *(const LAS bf16x8*)(lds + PG8_SB(b, h) + boff + n * 2048 + k * 1024); } while (0)
#define PG8_MMA(ai, bj, At, Bt) do { __builtin_amdgcn_s_setprio(1); _Pragma("unroll") for (int m = 0; m < 4; ++m) _Pragma("unroll") for (int n = 0; n < 2; ++n) _Pragma("unroll") for (int k = 0; k < 2; ++k) \
        acc[ai][bj][m][n] = __builtin_amdgcn_mfma_f32_16x16x32_bf16(Bt[n][k], At[m][k], acc[ai][bj][m][n], 0, 0, 0); __builtin_amdgcn_s_setprio(0); } while (0)
#define PG8_WAIT_V(n) asm volatile("s_waitcnt vmcnt(" #n ")" ::: "memory")
#define PG8_WAIT_L(n) asm volatile("s_waitcnt lgkmcnt(" #n ")" ::: "memory")
#define PG8_BAR __builtin_amdgcn_s_barrier()
#define PG8_SCHED __builtin_amdgcn_sched_barrier(0)
#define PG8_GOFF(u, dst) do { if (GATHER) { _Pragma("unroll") for (int i = 0; i < 2; ++i) _Pragma("unroll") for (int h = 0; h < 2; ++h) { const int x = sR[i] + 128 * h; \
        const int tok = (x < (u).nrows) ? ((u).ridx[x] >> 1) : 0; dst[h][i] = (unsigned)tok * lda + (unsigned)sC[i] * 2u; } } } while (0)
    Unit cur, nxt; int ui = 0;
    if (!S.next(0, cur)) return;
    f32x4 acc[2][2][4][2];
#pragma unroll
    for (int a = 0; a < 2; ++a)
#pragma unroll
        for (int b = 0; b < 2; ++b)
#pragma unroll
            for (int m = 0; m < 4; ++m)
#pragma unroll
                for (int n = 0; n < 2; ++n) acc[a][b][m][n] = (f32x4){0.f, 0.f, 0.f, 0.f};
    bf16x8 At[4][2], B0[2][2], B1[2][2];
    const char* cA = cur.A; const char* cB = cur.B;
    PG8_GOFF(cur, cvA);
    PG8_STGB(PG8_SB(0, 0), cB, 0); PG8_STGA(PG8_SA(0, 0), cA, 0, false); PG8_STGB(PG8_SB(0, 1), cB, 1); PG8_STGA(PG8_SA(0, 1), cA, 1, false);
    if (wr == 1) PG8_BAR;
    PG8_WAIT_V(4); PG8_BAR;
    PG8_STGB(PG8_SB(1, 0), cB + kstep, 0); PG8_STGA(PG8_SA(1, 0), cA + kstep, 0, false); PG8_STGB(PG8_SB(1, 1), cB + kstep, 1);
    PG8_WAIT_V(6); PG8_BAR;
    for (;;) {
        const bool has_next = S.next(ui + 1, nxt);
        const char* nA = has_next ? nxt.A : cA; const char* nB = has_next ? nxt.B : cB;
        if (GATHER) { if (has_next) { PG8_GOFF(nxt, nvA); } else {
#pragma unroll
            for (int i = 0; i < 2; ++i)
#pragma unroll
                for (int h = 0; h < 2; ++h) nvA[h][i] = cvA[h][i]; } }
        for (int t = 0; t < nt; t += 2) {
            const bool last = (t == nt - 2);
            const char* a1 = cA + (size_t)(t + 1) * kstep;
            const char* a2 = last ? nA : cA + (size_t)(t + 2) * kstep; const char* b2 = last ? nB : cB + (size_t)(t + 2) * kstep;
            const char* a3 = a2 + kstep; const char* b3 = b2 + kstep;
            PG8_LDB(B0, 0, 0); PG8_SCHED; PG8_LDA(At, 0, 0); PG8_STGA(PG8_SA(1, 1), a1, 1, false);
            PG8_WAIT_L(8); PG8_BAR; PG8_WAIT_L(0); PG8_MMA(0, 0, At, B0); PG8_BAR; PG8_SCHED;
            PG8_LDB(B1, 0, 1); PG8_STGB(PG8_SB(0, 0), b2, 0);
            PG8_BAR; PG8_WAIT_L(0); PG8_MMA(0, 1, At, B1); PG8_BAR;
            PG8_LDA(At, 0, 1); PG8_STGA(PG8_SA(0, 0), a2, 0, last);
            PG8_BAR; PG8_WAIT_L(0); PG8_MMA(1, 0, At, B0); PG8_BAR; PG8_SCHED;
            PG8_STGB(PG8_SB(0, 1), b2, 1);
            PG8_WAIT_V(6); PG8_BAR; PG8_MMA(1, 1, At, B1); PG8_BAR;
            PG8_LDB(B0, 1, 0); PG8_SCHED; PG8_LDA(At, 1, 0); PG8_STGA(PG8_SA(0, 1), a2, 1, last);
            PG8_WAIT_L(8); PG8_BAR; PG8_WAIT_L(0); PG8_MMA(0, 0, At, B0); PG8_BAR; PG8_SCHED;
            PG8_LDB(B1, 1, 1); PG8_STGB(PG8_SB(1, 0), b3, 0);
            PG8_BAR; PG8_WAIT_L(0); PG8_MMA(0, 1, At, B1); PG8_BAR;
            PG8_LDA(At, 1, 1); PG8_STGA(PG8_SA(1, 0), a3, 0, last);
            PG8_BAR; PG8_WAIT_L(0); PG8_MMA(1, 0, At, B0); PG8_BAR; PG8_SCHED;
            PG8_STGB(PG8_SB(1, 1), b3, 1);
            PG8_WAIT_V(6); PG8_BAR; PG8_MMA(1, 1, At, B1); PG8_BAR;
        }
        E(acc, cur, wr, wc, fr, fq);
        if (!has_next) break;
#pragma unroll
        for (int a = 0; a < 2; ++a)
#pragma unroll
            for (int b = 0; b < 2; ++b)
#pragma unroll
                for (int m = 0; m < 4; ++m)
#pragma unroll
                    for (int n = 0; n < 2; ++n) acc[a][b][m][n] = (f32x4){0.f, 0.f, 0.f, 0.f};
        cur = nxt; cA = nA; cB = nB; ++ui;
        if (GATHER) {
#pragma unroll
            for (int i = 0; i < 2; ++i)
#pragma unroll
                for (int h = 0; h < 2; ++h) cvA[h][i] = nvA[h][i]; }
    }
    PG8_WAIT_V(0);
    if (wr == 0) PG8_BAR;
    PG8_BAR;
#undef PG8_SA
#undef PG8_SB
#undef PG8_STG
#undef PG8_STGA
#undef PG8_STGB
#undef PG8_LDA
#undef PG8_LDB
#undef PG8_MMA
#undef PG8_WAIT_V
#undef PG8_WAIT_L
#undef PG8_BAR
#undef PG8_SCHED
#undef PG8_GOFF
}

struct DenseOrder {
    const char* A; const char* B; unsigned lda, ldb; int nM, nN, nwg, G, c;
    __device__ void init(const void* A_, const void* B_, unsigned lda_, unsigned ldb_, int M, int N, int G_, int c_) { A = (const char*)A_; B = (const char*)B_; lda = lda_; ldb = ldb_; nM = M / BM; nN = N / BM; nwg = nM * nN; G = G_; c = c_; }
    __device__ bool next(int i, Unit& u) const {
        const long L = (long)i * G + c; if (L >= nwg) return false;
        int wgid = (int)L; { const int q = nwg / NXCD, r = nwg % NXCD, xcd = wgid % NXCD, off = wgid / NXCD; wgid = (xcd < r ? xcd * (q + 1) : r * (q + 1) + (xcd - r) * q) + off; }
        const int nig = WGM * nN, gid = wgid / nig, fm = gid * WGM, gsz = (nM - fm) < WGM ? (nM - fm) : WGM;
        const int pm = fm + ((wgid % nig) % gsz), pn = (wgid % nig) / gsz;
        u.A = A + (size_t)pm * BM * lda; u.B = B + (size_t)pn * BM * ldb; u.ridx = nullptr; u.wl = nullptr; u.nrows = BM; u.r0 = pm * BM; u.c0 = pn * BM; u.aux = 0; return true;
    }
};
}
struct Args { const float* in[36]; float* out; unsigned char* ws; int ph_lo, ph_hi, flags, pad; };
struct Ctx {
    const float* const* in; float* out; unsigned char* ws; unsigned char* ws0;
    LAS unsigned char* lds; unsigned char* ldsg;
    int tid, lane, wave, G, bid, vcu, flags;
};
__device__ __forceinline__ void fresh(Ctx& C) {
    int t_ = threadIdx.x; asm volatile("" : "+v"(t_)); C.tid = t_; C.lane = t_ & 63; C.wave = __builtin_amdgcn_readfirstlane(t_ >> 6);
    int b_ = blockIdx.x; asm volatile("" : "+s"(b_)); C.bid = b_; int g_ = gridDim.x; asm volatile("" : "+s"(g_)); C.G = g_;
    C.vcu = (g_ % 8 == 0) ? (b_ % 8) * (g_ / 8) + b_ / 8 : b_;
    unsigned char* w_ = C.ws0; asm volatile("" : "+s"(w_)); C.ws = w_;
}
enum { IN_X = 0, IN_C, IN_ADAW, IN_ADAB, IN_N1G, IN_N2G, IN_WIN, IN_QNG, IN_KNG, IN_LAM, IN_SUBLN, IN_MU, IN_WUP, IN_W0, IN_AUP, IN_A0, IN_GUP, IN_KK, IN_KA, IN_RK, IN_LNG, IN_LNB,
       IN_GAUP, IN_GAB, IN_GNG, IN_PA, IN_PR, IN_PG, IN_WOUT, IN_RGW, IN_RGB, IN_REW, IN_REB, IN_EG, IN_EU, IN_ED };

__device__ __forceinline__ void transpose_item(const float* __restrict__ src, int ldn, int ns0, int nvalid, bf16_t* dst, int ldk, int nd0, int k0, LAS float* scr, int lane) {
    const int kq = lane >> 3, n4 = (lane & 7) * 4;
    f32x4 v[8];
#pragma unroll
    for (int i = 0; i < 8; ++i) { const int kk = 8 * i + kq; v[i] = (n4 < nvalid) ? *(const f32x4*)(src + (size_t)kk * ldn + ns0 + n4) : (f32x4){0.f, 0.f, 0.f, 0.f}; }
#pragma unroll
    for (int i = 0; i < 8; ++i) { const int kk = 8 * i + kq; LAS float* d = scr + kk * 33 + n4; d[0] = v[i][0]; d[1] = v[i][1]; d[2] = v[i][2]; d[3] = v[i][3]; }
    asm volatile("s_waitcnt lgkmcnt(0)" ::: "memory");
    const int c = lane & 7;
#pragma unroll
    for (int j = 0; j < 4; ++j) { const int n = (lane >> 3) + 8 * j; const LAS float* s = scr + (8 * c) * 33 + n;
        u32x4 o; o.x = pk2(s[0 * 33], s[1 * 33]); o.y = pk2(s[2 * 33], s[3 * 33]); o.z = pk2(s[4 * 33], s[5 * 33]); o.w = pk2(s[6 * 33], s[7 * 33]);
        *(u32x4*)(dst + (size_t)(nd0 + n) * ldk + k0 + 8 * c) = o; }
    asm volatile("s_waitcnt lgkmcnt(0)" ::: "memory");
}

__device__ __forceinline__ void phase_prologue(const Ctx& C) {
    float* cact = (float*)C.ldsg;
    float* red = (float*)(C.ldsg + 32768);
    if (C.bid < 192) {
        for (int i = C.tid; i < 8192; i += NTHR) { const float v = C.in[IN_C][i]; cact[i] = siluf_(v); }
        __syncthreads();
        for (int it = C.bid; it < 192; it += C.G) {
            const int l = it / 96, jb = it % 96, jj = C.tid & 63, ks = C.tid >> 6;
            const float* W = C.in[IN_ADAW] + (size_t)l * 1024 * 6144 + jb * 64 + jj;
            float a[8];
#pragma unroll
            for (int b = 0; b < 8; ++b) a[b] = 0.f;
            for (int k = ks * 128; k < ks * 128 + 128; ++k) { const float w = W[(size_t)k * 6144];
#pragma unroll
                for (int b = 0; b < 8; ++b) a[b] += cact[b * 1024 + k] * w; }
#pragma unroll
            for (int b = 0; b < 8; ++b) red[(ks * 8 + b) * 64 + jj] = a[b];
            __syncthreads();
            { const int b = C.tid >> 6; float s = 0.f;
#pragma unroll
              for (int k2 = 0; k2 < 8; ++k2) s += red[(k2 * 8 + b) * 64 + jj];
              ((float*)(C.ws + WS_MOD))[((size_t)l * 8 + b) * 6144 + jb * 64 + jj] = s + C.in[IN_ADAB][l * 6144 + jb * 64 + jj]; }
            __syncthreads();
        }
    }
    __syncthreads();
    LAS float* scr = (LAS float*)(C.lds + 65536 + C.wave * 8448);
    const int gw = C.bid * NWAVES + C.wave, NGW = C.G * NWAVES;
    constexpr int I_WIN = 2 * 16 * 256, I_PROJ = 6 * 8 * 32, I_WOUT = 2 * 16 * 32, I_LW = 2 * 4 * 16;
    for (int it = gw; it < I_WIN + I_PROJ + I_WOUT + I_LW; it += NGW) {
        int r = it;
        if (r >= I_WIN + I_PROJ + I_WOUT) { r -= I_WIN + I_PROJ + I_WOUT; const int l = r / 64, q = r % 64, kb4 = q / 16, nb = q % 16;
            const float* src = (kb4 == 0) ? C.in[IN_WUP] + (size_t)l * 64 * 512 : (kb4 == 1) ? C.in[IN_AUP] + (size_t)l * 64 * 512 : C.in[IN_GUP] + (size_t)l * 128 * 512 + (size_t)(kb4 - 2) * 64 * 512;
            transpose_item(src, 512, 32 * nb, 32, ((bf16_t*)(C.ws + WS_LW)) + (size_t)l * 512 * 256, 256, 32 * nb, 64 * kb4, scr, C.lane); continue; }
        if (r < I_WIN) { const int l = r / 4096, q = r % 4096, kb = q / 256, nb = q % 256, n0 = 32 * nb;
            int ns0 = 0, nv = 32;
            if (n0 < 4352) ns0 = n0; else if (n0 < 7936) ns0 = n0 + 16; else if (n0 == 7936) { ns0 = 4352; nv = 16; } else nv = 0;
            transpose_item(C.in[IN_WIN] + (size_t)l * 1024 * NIN_ + (size_t)(64 * kb) * NIN_, NIN_, ns0, nv, ((bf16_t*)(C.ws + WS_WIN)) + (size_t)l * NP_ * 1024, 1024, n0, 64 * kb, scr, C.lane); continue; }
        r -= I_WIN;
        if (r < I_PROJ) { const int lb = r / 256, q = r % 256, kb = q / 32, nb = q % 32, l = lb / 3, br = lb % 3;
            const float* src = C.in[IN_PA + br] + (size_t)l * 512 * 1024 + (size_t)(64 * kb) * 1024;
            transpose_item(src, 1024, 32 * nb, 32, ((bf16_t*)(C.ws + WS_WPROJ)) + (size_t)(l * 3 + br) * 1024 * 512, 512, 32 * nb, 64 * kb, scr, C.lane); continue; }
        r -= I_PROJ;
        { const int l = r / 512, q = r % 512, kb = q / 32, nb = q % 32;
          transpose_item(C.in[IN_WOUT] + (size_t)l * 1024 * 1024 + (size_t)(64 * kb) * 1024, 1024, 32 * nb, 32, ((bf16_t*)(C.ws + WS_WOUT)) + (size_t)l * 1024 * 1024, 1024, 32 * nb, 64 * kb, scr, C.lane); }
    }
}

__device__ __forceinline__ void phase_rows(const Ctx& C, int l, int mode) {
    const int gw = C.bid * NWAVES + C.wave, NGW = C.G * NWAVES;
    const float* xin = (mode & 1) ? C.out : C.in[IN_X];
    for (int t = gw; t < T_; t += NGW) {
        const int b = t >> 11;
        f32x4 v[4];
#pragma unroll
        for (int j = 0; j < 4; ++j) v[j] = *(const f32x4*)(xin + (size_t)t * 1024 + 4 * C.lane + 256 * j);
        if (mode & 1) {
            const float* gt2 = ((float*)(C.ws + WS_MOD)) + ((size_t)(l - 1) * 8 + b) * 6144 + 5120;
#pragma unroll
            for (int j = 0; j < 4; ++j) { const int col = 4 * C.lane + 256 * j;
                const u32x2 y0 = *(const u32x2*)(((bf16_t*)(C.ws + WS_YS)) + (size_t)(2 * t) * 1024 + col), y1 = *(const u32x2*)(((bf16_t*)(C.ws + WS_YS)) + (size_t)(2 * t + 1) * 1024 + col);
                const f32x4 g = *(const f32x4*)(gt2 + col);
                v[j][0] += g[0] * (lo16(y0.x) + lo16(y1.x)); v[j][1] += g[1] * (hi16(y0.x) + hi16(y1.x));
                v[j][2] += g[2] * (lo16(y0.y) + lo16(y1.y)); v[j][3] += g[3] * (hi16(y0.y) + hi16(y1.y));
                *(f32x4*)(C.out + (size_t)t * 1024 + col) = v[j]; }
        }
        if (mode & 2) {
            float ss = 0.f;
#pragma unroll
            for (int j = 0; j < 4; ++j) ss += v[j][0] * v[j][0] + v[j][1] * v[j][1] + v[j][2] * v[j][2] + v[j][3] * v[j][3];
            ss = wave_sum(ss);
            const float rstd = rsqrtf(ss * (1.f / 1024.f) + 1e-6f);
            const float* md = ((float*)(C.ws + WS_MOD)) + ((size_t)l * 8 + b) * 6144;
#pragma unroll
            for (int j = 0; j < 4; ++j) { const int col = 4 * C.lane + 256 * j;
                const f32x4 g = *(const f32x4*)(C.in[IN_N1G] + l * 1024 + col), sh = *(const f32x4*)(md + col), sc = *(const f32x4*)(md + 1024 + col);
                float o[4];
#pragma unroll
                for (int e = 0; e < 4; ++e) o[e] = v[j][e] * rstd * g[e] * (1.f + sc[e]) + sh[e];
                u32x2 w; w.x = pk2(o[0], o[1]); w.y = pk2(o[2], o[3]);
                *(u32x2*)(((bf16_t*)(C.ws + WS_H)) + (size_t)t * 1024 + col) = w; }
        }
    }
}

struct EpiP {
    static constexpr bool PERM = true; unsigned char* ws;
    __device__ __forceinline__ void operator()(const f32x4 (&acc)[2][2][4][2], const pg8::Unit& u, int wr, int wc, int fr, int fq) const {
        const int pn = u.c0 >> 8;
        size_t off; int mode = 0, ld = 0, hdsh = 6, nh = 8, cs0;
        if (pn < 2)        { off = WS_QH; mode = 1; hdsh = 6; nh = 8; cs0 = u.c0; }
        else if (pn < 4)   { off = WS_KH; mode = 1; hdsh = 6; nh = 8; cs0 = u.c0 - 512; }
        else if (pn < 6)   { off = WS_AV; ld = 512; cs0 = u.c0 - 1024; }
        else if (pn < 13)  { off = WS_RWS; ld = 1792; cs0 = u.c0 - 1536; }
        else if (pn < 14)  { off = WS_GQ; mode = 1; hdsh = 6; nh = 4; cs0 = 0; }
        else if (pn < 15)  { off = WS_GK; mode = 1; hdsh = 6; nh = 4; cs0 = 0; }
        else if (pn < 17)  { off = WS_GV; mode = 1; hdsh = 7; nh = 4; cs0 = u.c0 - 3840; }
        else if (pn < 19)  { off = WS_GG; mode = 1; hdsh = 7; nh = 4; cs0 = u.c0 - 4352; }
        else if (pn < 31)  { off = WS_GATES; ld = 3072; cs0 = u.c0 - 4864; }
        else               { off = WS_GAD; mode = 2; ld = 16; cs0 = 0; }
        bf16_t* base = (bf16_t*)(ws + off);
#pragma unroll
        for (int ai = 0; ai < 2; ++ai)
#pragma unroll
            for (int m = 0; m < 4; ++m) { const int row = u.r0 + 128 * ai + 64 * wr + 16 * m + fr; const int b = row >> 11, s = row & 2047;
#pragma unroll
                for (int bj = 0; bj < 2; ++bj) { const f32x4 v0 = acc[ai][bj][m][0], v1 = acc[ai][bj][m][1];
                    u32x4 w; w.x = pk2(v0[0], v0[1]); w.y = pk2(v0[2], v0[3]); w.z = pk2(v1[0], v1[1]); w.w = pk2(v1[2], v1[3]);
                    const int cs = cs0 + 128 * bj + 32 * wc + 8 * fq;
                    if (mode == 1) { const int hidx = cs >> hdsh, din = cs & ((1 << hdsh) - 1); *(u32x4*)(base + ((((size_t)b * nh + hidx) * S_ + s) << hdsh) + din) = w; }
                    else if (mode == 0) { *(u32x4*)(base + (size_t)row * ld + cs) = w; }
                    else { if (cs < 16) *(u32x4*)(base + (size_t)row * 16 + cs) = w; } } }
    }
};
struct EpiMerge {
    static constexpr bool PERM = true; const bf16_t* GATES; bf16_t* MG;
    __device__ __forceinline__ void operator()(const f32x4 (&acc)[2][2][4][2], const pg8::Unit& u, int wr, int wc, int fr, int fq) const {
#pragma unroll
        for (int ai = 0; ai < 2; ++ai)
#pragma unroll
            for (int m = 0; m < 4; ++m) { const size_t row = (size_t)(u.r0 + 128 * ai + 64 * wr + 16 * m + fr); const int col = u.c0 + 32 * wc + 8 * fq;
#pragma unroll
                for (int bj = 0; bj < 2; ++bj) { const f32x4 v0 = acc[ai][bj][m][0], v1 = acc[ai][bj][m][1];
                    const u32x4 g = *(const u32x4*)(GATES + row * 3072 + u.aux * 1024 + col + 128 * bj);
                    float o[8];
                    o[0] = sigmoidf_(lo16(g.x)) * v0[0]; o[1] = sigmoidf_(hi16(g.x)) * v0[1]; o[2] = sigmoidf_(lo16(g.y)) * v0[2]; o[3] = sigmoidf_(hi16(g.y)) * v0[3];
                    o[4] = sigmoidf_(lo16(g.z)) * v1[0]; o[5] = sigmoidf_(hi16(g.z)) * v1[1]; o[6] = sigmoidf_(lo16(g.w)) * v1[2]; o[7] = sigmoidf_(hi16(g.w)) * v1[3];
                    bf16_t* mp = MG + row * 1024 + col + 128 * bj;
                    if (u.aux > 0) { const u32x4 p = *(const u32x4*)mp;
                        o[0] += lo16(p.x); o[1] += hi16(p.x); o[2] += lo16(p.y); o[3] += hi16(p.y); o[4] += lo16(p.z); o[5] += hi16(p.z); o[6] += lo16(p.w); o[7] += hi16(p.w); }
                    u32x4 w; w.x = pk2(o[0], o[1]); w.y = pk2(o[2], o[3]); w.z = pk2(o[4], o[5]); w.w = pk2(o[6], o[7]);
                    *(u32x4*)mp = w; } }
    }
};
struct EpiOut {
    static constexpr bool PERM = false; const float* xin; float* out; const float* gt;
    __device__ __forceinline__ void operator()(const f32x4 (&acc)[2][2][4][2], const pg8::Unit& u, int wr, int wc, int fr, int fq) const {
#pragma unroll
        for (int ai = 0; ai < 2; ++ai)
#pragma unroll
            for (int m = 0; m < 4; ++m) { const int row = u.r0 + 128 * ai + 64 * wr + 16 * m + fr; const int b = row >> 11;
#pragma unroll
                for (int bj = 0; bj < 2; ++bj)
#pragma unroll
                    for (int n = 0; n < 2; ++n) { const int col = u.c0 + 128 * bj + 32 * wc + 16 * n + 4 * fq;
                        const f32x4 x = *(const f32x4*)(xin + (size_t)row * 1024 + col), g = *(const f32x4*)(gt + (size_t)b * 6144 + col);
                        *(f32x4*)(out + (size_t)row * 1024 + col) = x + g * acc[ai][bj][m][n]; } }
    }
};
struct EpiHid {
    static constexpr bool PERM = true; bf16_t* HID;
    __device__ __forceinline__ void operator()(const f32x4 (&acc)[2][2][4][2], const pg8::Unit& u, int wr, int wc, int fr, int fq) const {
#pragma unroll
        for (int ai = 0; ai < 2; ++ai)
#pragma unroll
            for (int m = 0; m < 4; ++m) { bf16_t* rowp = HID + (size_t)(u.r0 + 128 * ai + 64 * wr + 16 * m + fr) * 512 + u.c0 + 32 * wc + 8 * fq;
                float o[8];
#pragma unroll
                for (int n = 0; n < 2; ++n)
#pragma unroll
                    for (int j = 0; j < 4; ++j) o[4 * n + j] = siluf_(acc[ai][0][m][n][j]) * acc[ai][1][m][n][j];
                u32x4 w; w.x = pk2(o[0], o[1]); w.y = pk2(o[2], o[3]); w.z = pk2(o[4], o[5]); w.w = pk2(o[6], o[7]);
                *(u32x4*)rowp = w; }
    }
};
struct EpiDown {
    static constexpr bool PERM = true; bf16_t* YS;
    __device__ __forceinline__ void operator()(const f32x4 (&acc)[2][2][4][2], const pg8::Unit& u, int wr, int wc, int fr, int fq) const {
#pragma unroll
        for (int ai = 0; ai < 2; ++ai)
#pragma unroll
            for (int m = 0; m < 4; ++m) { const int rloc = 128 * ai + 64 * wr + 16 * m + fr;
                if (rloc < u.nrows) { const int slot = u.ridx[rloc]; const float wgt = u.wl[rloc];
                    bf16_t* rowp = YS + (size_t)slot * 1024 + u.c0 + 32 * wc + 8 * fq;
#pragma unroll
                    for (int bj = 0; bj < 2; ++bj) { const f32x4 v0 = acc[ai][bj][m][0] * wgt, v1 = acc[ai][bj][m][1] * wgt;
                        u32x4 w; w.x = pk2(v0[0], v0[1]); w.y = pk2(v0[2], v0[3]); w.z = pk2(v1[0], v1[1]); w.w = pk2(v1[2], v1[3]);
                        *(u32x4*)(rowp + 128 * bj) = w; } } }
    }
};
struct WinOrder {
    const char* A; const char* B; int G, c;
    __device__ bool next(int i, pg8::Unit& u) const {
        constexpr int nM = 64, nN = 24, nwg = nM * nN;
        const long L = (long)i * G + c; if (L >= nwg) return false;
        int wgid = (int)L; { const int q = nwg / 8, r = nwg % 8, xcd = wgid % 8, off = wgid / 8; wgid = (xcd < r ? xcd * (q + 1) : r * (q + 1) + (xcd - r) * q) + off; }
        const int nig = 8 * nN, gid = wgid / nig, fm = gid * 8;
        const int pm = fm + ((wgid % nig) % 8); int pn = (wgid % nig) / 8; pn = (pn < 23) ? pn : 31;
        u.A = A + (size_t)pm * 256 * 2048; u.B = B + (size_t)pn * 256 * 2048; u.ridx = nullptr; u.wl = nullptr; u.nrows = 256; u.r0 = pm * 256; u.c0 = pn * 256; u.aux = 0; return true;
    }
};
struct GateOrder {
    const char* A; const char* B; int q;
    __device__ bool next(int i, pg8::Unit& u) const {
        if (i >= 4) return false;
        const int pm = q >> 1, pn = 23 + 4 * (q & 1) + i;
        u.A = A + (size_t)pm * 256 * 2048; u.B = B + (size_t)pn * 256 * 2048; u.ridx = nullptr; u.wl = nullptr; u.nrows = 256; u.r0 = pm * 256; u.c0 = pn * 256; u.aux = 0; return true;
    }
};
struct MergeOrder {
    const bf16_t *O0, *O1, *O2; const bf16_t* W; int G, c;
    __device__ bool next(int i, pg8::Unit& u) const {
        const int br = i % 3, tile = c + (i / 3) * G; if (tile >= 256) return false;
        const int pm = tile >> 2, pn = tile & 3;
        const bf16_t* Ob = (br == 0) ? O0 : ((br == 1) ? O1 : O2); u.A = (const char*)(Ob + (size_t)pm * 256 * 512); u.B = (const char*)(W + (size_t)br * 1024 * 512 + (size_t)pn * 256 * 512);
        u.ridx = nullptr; u.wl = nullptr; u.nrows = 256; u.r0 = pm * 256; u.c0 = pn * 256; u.aux = br; return true;
    }
};
struct MoeOrder {
    const LAS int* tab; const char* A; const char* B; const int* LIST; const float* WL; int G, c, down;
    __device__ bool next(int i, pg8::Unit& u) const {
        const int L = i * G + c, R = L >> 2, ct = L & 3; if (R >= tab[32]) return false;
        int e = 0;
#pragma unroll 1
        while (tab[e + 1] <= R) ++e;
        const int rt = R - tab[e], n = tab[33 + e] - 256 * rt;
        u.nrows = n < 256 ? n : 256; u.ridx = LIST + (size_t)e * ECAP + 256 * rt; u.wl = WL + (size_t)e * ECAP + 256 * rt; u.aux = e;
        if (!down) { u.A = A; u.B = B + ((size_t)e * 1024 + 256 * ct) * 2048; u.r0 = 256 * R; u.c0 = 128 * ct; }
        else       { u.A = A + (size_t)256 * R * 1024; u.B = B + ((size_t)e * 1024 + 256 * ct) * 1024; u.r0 = 256 * R; u.c0 = 256 * ct; }
        return true;
    }
};
__device__ __forceinline__ void moe_build_table(const Ctx& C, int l) {
    LAS int* tab = (LAS int*)(C.lds + LDS_SCHED);
    if (C.tid == 0) { int acc = 0;
        for (int e = 0; e < 32; ++e) { const int n = (int)__hip_atomic_load(((unsigned*)(C.ws + WS_CTL)) + CW_CNT + l * 2048 + 64 * e, __ATOMIC_RELAXED, __HIP_MEMORY_SCOPE_AGENT); tab[e] = acc; tab[33 + e] = n; acc += (n + 255) >> 8; }
        tab[32] = acc; }
    __syncthreads();
}
__device__ __forceinline__ float mixv(float x, float prev, float mu) { return x + (prev - x) * mu; }
__device__ __forceinline__ void phase_prep(const Ctx& C, int l) {
    bf16_t* xs = (bf16_t*)C.ldsg;
    bf16_t* vts = (bf16_t*)(C.ldsg + 32768);
    float* gs = (float*)(C.ldsg + 16896);
    constexpr int PS_STG = 20480, PS_ARR = 32 * 144, PS_SLOT = 6 * PS_ARR, PS_RED = 131072;
    const int tid = C.tid, lane = C.lane;
    const float* mu = C.in[IN_MU] + l * 1792;
    for (int item = C.bid; item < T_ / 32; item += C.G) {
        const int t0 = item * 32, b = t0 >> 11, s0 = t0 & 2047;
        const bf16_t* RWt = ((const bf16_t*)(C.ws + WS_RWS)) + (size_t)t0 * 1792;
        if (!(C.flags & 16)) { const int g = tid >> 5, tok = tid & 31;
          bf16_t* p = ((bf16_t*)(C.ws + (g < 8 ? WS_QH : WS_KH))) + (((size_t)b * 8 + (g & 7)) * S_ + s0 + tok) * 64; u32x4 raw[8]; float ss = 0.f;
#pragma unroll
          for (int i = 0; i < 8; ++i) { raw[i] = *(const u32x4*)(p + 8 * i);
#pragma unroll
              for (int e = 0; e < 4; ++e) { const float a = lo16(raw[i][e]), c2 = hi16(raw[i][e]); ss += a * a + c2 * c2; } }
          const float rstd = rsqrtf(ss * (1.f / 64.f) + 1e-6f) * ((g < 8) ? 0.125f : 1.0f);
          const float* gn = (g < 8) ? C.in[IN_QNG] + l * 64 : C.in[IN_KNG] + l * 64;
#pragma unroll
          for (int i = 0; i < 8; ++i) { u32x4 w;
#pragma unroll
              for (int e = 0; e < 4; ++e) w[e] = pk2(lo16(raw[i][e]) * rstd * gn[8 * i + 2 * e], hi16(raw[i][e]) * rstd * gn[8 * i + 2 * e + 1]);
              *(u32x4*)(p + 8 * i) = w; } }
#pragma unroll
        for (int i = 0; i < 4; ++i) { const int idx = tid + 512 * i, tok = idx >> 6, c8 = idx & 63;
            *(u32x4*)(vts + tok * 512 + c8 * 8) = *(const u32x4*)(((const bf16_t*)(C.ws + WS_AV)) + (size_t)(t0 + tok) * 512 + c8 * 8); }
        { const int tok = tid >> 4, i = tid & 15; gs[tok * 16 + i] = bf2f(((const bf16_t*)(C.ws + WS_GAD))[(size_t)(t0 + tok) * 16 + i]); }
        if (tid < 256) { const int j = tid, col = 1536 + j; const float m_ = mu[1536 + j];
            float prev = (s0 == 0) ? 0.f : bf2f(RWt[col - 1792]);
#pragma unroll
            for (int t = 0; t < 32; ++t) { const float x = bf2f(RWt[(size_t)t * 1792 + col]); const float mv = mixv(x, prev, m_); prev = x;
                float val; if (j < 64) { const float e2 = __expf(2.f * mv); val = 1.f - 2.f / (e2 + 1.f); } else if (j < 128) val = mv; else val = sigmoidf_(mv);
                xs[t * 264 + j] = f2bf(val); } }
        __syncthreads();
        if (!(C.flags & 32)) { u32x4 o[4];
#pragma unroll
          for (int q = 0; q < 4; ++q)
#pragma unroll
              for (int e = 0; e < 4; ++e) { const unsigned a = vts[(8 * q + 2 * e) * 512 + tid], c2 = vts[(8 * q + 2 * e + 1) * 512 + tid]; o[q][e] = a | (c2 << 16); }
          bf16_t* dst = ((bf16_t*)(C.ws + WS_VT)) + ((((size_t)b * 4 + (tid >> 7)) * 64 + (s0 >> 5)) * 128 + (tid & 127)) * 32;
#pragma unroll
          for (int q = 0; q < 4; ++q) *(u32x4*)(dst + 8 * q) = o[q]; }
        if (!(C.flags & 128)) { const int j = tid & 255, half = tid >> 8; float au[16];
#pragma unroll
          for (int i = 0; i < 16; ++i) au[i] = C.in[IN_GAUP][(size_t)l * 16 * 256 + i * 256 + j];
          const float ab = C.in[IN_GAB][l * 256 + j];
          float* la = ((float*)(C.ws + WS_LA)) + (((size_t)b * 4 + (j >> 6)) * S_ + s0) * 64 + (j & 63);
          for (int t = half * 16; t < half * 16 + 16; ++t) { float z = ab;
#pragma unroll
              for (int i = 0; i < 16; ++i) z += gs[t * 16 + i] * au[i];
              la[(size_t)t * 64] = -softplusf_(-z) * (1.f / 16.f); } }
        __syncthreads();
        if (!(C.flags & 64)) {
        const int r = lane & 31, hh = lane >> 5, w = C.wave, slot = w & 3, tile = w >> 2;
        const bf16_t* LW = ((const bf16_t*)(C.ws + WS_LW)) + (size_t)l * 512 * 256;
        const bool has_prev = !(s0 == 0 && r == 0);
        const bf16_t* xrow = RWt + (size_t)r * 1792; const bf16_t* xprev = xrow - 1792;
        float* red = (float*)(C.ldsg + PS_RED);
#pragma unroll 1
        for (int pass = 0; pass < 2; ++pass) {
            const int hd = 4 * pass + slot, ch0 = 64 * hd + 32 * tile;
            unsigned char* stg = C.ldsg + PS_STG + slot * PS_SLOT + r * 144 + (32 * tile + 4 * hh) * 2;
            float ssq = 0.f, bon = 0.f;
            f32x16 aw, aa, ag;
#pragma unroll
            for (int i = 0; i < 16; ++i) { aw[i] = 0.f; aa[i] = 0.f; ag[i] = 0.f; }
            const bf16_t* wrow = LW + (size_t)(ch0 + r) * 256 + 8 * hh;
#pragma unroll
            for (int s = 0; s < 4; ++s) aw = MFMA32(*(const bf16x8*)(wrow + 16 * s), *(const bf16x8*)(xs + r * 264 + 16 * s + 8 * hh), aw);
#pragma unroll
            for (int s = 0; s < 4; ++s) aa = MFMA32(*(const bf16x8*)(wrow + 64 + 16 * s), *(const bf16x8*)(xs + r * 264 + 64 + 16 * s + 8 * hh), aa);
#pragma unroll
            for (int s = 0; s < 8; ++s) ag = MFMA32(*(const bf16x8*)(wrow + 128 + 16 * s), *(const bf16x8*)(xs + r * 264 + 128 + 16 * s + 8 * hh), ag);
#pragma unroll
            for (int g = 0; g < 4; ++g) { const int ch = ch0 + 8 * g + 4 * hh;
                const size_t o = (size_t)(t0 + r) * 512 + ch;
                const f32x4 w0 = *(const f32x4*)(C.in[IN_W0] + l * 512 + ch), a0 = *(const f32x4*)(C.in[IN_A0] + l * 512 + ch);
                const f32x4 mur = *(const f32x4*)(mu + ch), muk = *(const f32x4*)(mu + 512 + ch), muv = *(const f32x4*)(mu + 1024 + ch);
                const f32x4 kkc = *(const f32x4*)(C.in[IN_KK] + l * 512 + ch), kac = *(const f32x4*)(C.in[IN_KA] + l * 512 + ch), rkc = *(const f32x4*)(C.in[IN_RK] + l * 512 + ch);
                const u32x2 ur = *(const u32x2*)(xrow + ch), uk = *(const u32x2*)(xrow + 512 + ch), uv = *(const u32x2*)(xrow + 1024 + ch);
                u32x2 pr = {0u, 0u}, pk = {0u, 0u}, pv = {0u, 0u};
                if (has_prev) { pr = *(const u32x2*)(xprev + ch); pk = *(const u32x2*)(xprev + 512 + ch); pv = *(const u32x2*)(xprev + 1024 + ch); }
                const float xr_[4] = {lo16(ur.x), hi16(ur.x), lo16(ur.y), hi16(ur.y)}, xk_[4] = {lo16(uk.x), hi16(uk.x), lo16(uk.y), hi16(uk.y)}, xv_[4] = {lo16(uv.x), hi16(uv.x), lo16(uv.y), hi16(uv.y)};
                const float qr_[4] = {lo16(pr.x), hi16(pr.x), lo16(pr.y), hi16(pr.y)}, qk_[4] = {lo16(pk.x), hi16(pk.x), lo16(pk.y), hi16(pk.y)}, qv_[4] = {lo16(pv.x), hi16(pv.x), lo16(pv.y), hi16(pv.y)};
                float ld4[4], g4[4], r4[4], kp4[4], v4[4], kr4[4], bb4[4];
#pragma unroll
                for (int e = 0; e < 4; ++e) { const int i = 4 * g + e;
                    const float wv = -softplusf_(-(w0[e] + aw[i])) - 0.5f; ld4[e] = -__expf(wv);
                    const float a = sigmoidf_(a0[e] + aa[i]); g4[e] = ag[i];
                    const float rr = mixv(xr_[e], qr_[e], mur[e]), kk = mixv(xk_[e], qk_[e], muk[e]), vv = mixv(xv_[e], qv_[e], muv[e]);
                    const float kk_ = kk * kkc[e]; kr4[e] = kk_; bb4[e] = kk_ * a; ssq += kk_ * kk_;
                    const float kp = kk * (1.f + (a - 1.f) * kac[e]); bon += rr * kp * rkc[e];
                    r4[e] = rr; kp4[e] = kp; v4[e] = vv; }
                *(f32x4*)(((float*)(C.ws + WS_RLD)) + o) = (f32x4){ld4[0], ld4[1], ld4[2], ld4[3]};
                u32x2 t2; unsigned char* sp = stg + 16 * g;
                t2.x = pk2(g4[0], g4[1]); t2.y = pk2(g4[2], g4[3]); *(u32x2*)(sp) = t2;
                t2.x = pk2(r4[0], r4[1]); t2.y = pk2(r4[2], r4[3]); *(u32x2*)(sp + PS_ARR) = t2;
                t2.x = pk2(kp4[0], kp4[1]); t2.y = pk2(kp4[2], kp4[3]); *(u32x2*)(sp + 2 * PS_ARR) = t2;
                t2.x = pk2(v4[0], v4[1]); t2.y = pk2(v4[2], v4[3]); *(u32x2*)(sp + 3 * PS_ARR) = t2;
                t2.x = pk2(kr4[0], kr4[1]); t2.y = pk2(kr4[2], kr4[3]); *(u32x2*)(sp + 4 * PS_ARR) = t2;
                t2.x = pk2(bb4[0], bb4[1]); t2.y = pk2(bb4[2], bb4[3]); *(u32x2*)(sp + 5 * PS_ARR) = t2;
                __builtin_amdgcn_sched_barrier(0); }
            ssq += xor32(ssq, lane); bon += xor32(bon, lane);
            if (hh == 0) { red[((slot * 2 + tile) * 32 + r) * 2] = ssq; red[((slot * 2 + tile) * 32 + r) * 2 + 1] = bon; }
            __syncthreads();
#pragma unroll 4
            for (int i = 0; i < 12; ++i) { const int P = tid + 512 * i, sl = P / 1536, rem = P - sl * 1536, arr = rem >> 8, row = (rem & 255) >> 3, piece = rem & 7;
                const u32x4 v = *(const u32x4*)(C.ldsg + PS_STG + sl * PS_SLOT + arr * PS_ARR + row * 144 + piece * 16);
                const size_t aoff = (arr == 0) ? WS_RG : (arr == 1) ? WS_RR : (arr == 2) ? WS_RK : (arr == 3) ? WS_RV : (arr == 4) ? WS_RKK : WS_RBB;
                *(u32x4*)(((bf16_t*)(C.ws + aoff)) + (size_t)(t0 + row) * 512 + (4 * pass + sl) * 64 + piece * 8) = v; }
            if (tid < 128) { const int sl = tid >> 5, tk = tid & 31;
                const float sq = red[((sl * 2) * 32 + tk) * 2] + red[((sl * 2 + 1) * 32 + tk) * 2], bn = red[((sl * 2) * 32 + tk) * 2 + 1] + red[((sl * 2 + 1) * 32 + tk) * 2 + 1];
                const float nrm = fmaxf(sqrtf(sq), 1e-12f);
                ((float*)(C.ws + WS_RC))[(size_t)(t0 + tk) * 8 + 4 * pass + sl] = 1.f / (nrm * nrm);
                ((float*)(C.ws + WS_RBON))[(size_t)(t0 + tk) * 8 + 4 * pass + sl] = bn; }
            __syncthreads();
        }
        }
        __syncthreads();
    }
}

constexpr int RW_WGS = 128;
__device__ __forceinline__ void rwkv_wg(const Ctx& C0, int l, int item) {
    Ctx C = C0; fresh(C);
    const int bh = item >> 1, rh = item & 1, b = bh >> 3, h = bh & 7, tid = C.tid, lane = C.lane;
    float* dec = (float*)C.ldsg; float* skk = dec + 2048; float* sbb = dec + 4096; float* skp = dec + 6144; float* srr = dec + 8192;
    bf16_t* svv = (bf16_t*)(C.ldsg + 40960);
    float* yb = (float*)(C.ldsg + 45056);
    const int rloc = 4 * C.wave + (lane >> 4), row = 32 * rh + rloc, kq = lane & 15;
    float s0 = 0.f, s1 = 0.f, s2 = 0.f, s3 = 0.f;
    const int lstep = tid >> 4, lc4 = tid & 15;
    const size_t o0 = ((size_t)b * S_ + lstep) * 512 + h * 64 + 4 * lc4; const int lo = lstep * 64 + 4 * lc4;
    f32x4 nld = *(const f32x4*)(((const float*)(C.ws + WS_RLD)) + o0);
    u32x2 nkk = *(const u32x2*)(((const bf16_t*)(C.ws + WS_RKK)) + o0), nbb = *(const u32x2*)(((const bf16_t*)(C.ws + WS_RBB)) + o0), nkp = *(const u32x2*)(((const bf16_t*)(C.ws + WS_RK)) + o0),
          nrr = *(const u32x2*)(((const bf16_t*)(C.ws + WS_RR)) + o0), nvv = *(const u32x2*)(((const bf16_t*)(C.ws + WS_RV)) + o0);
    float ncs = ((const float*)(C.ws + WS_RC))[((size_t)b * S_ + lstep) * 8 + h];
    for (int blk = 0; blk < S_ / 32; ++blk) {
        const size_t tb = (size_t)b * S_ + blk * 32;
        { f32x4 d; d[0] = __expf(nld[0]); d[1] = __expf(nld[1]); d[2] = __expf(nld[2]); d[3] = __expf(nld[3]);
          *(f32x4*)(dec + lo) = d;
          *(f32x4*)(skk + lo) = (f32x4){lo16(nkk.x), hi16(nkk.x), lo16(nkk.y), hi16(nkk.y)};
          *(f32x4*)(sbb + lo) = (f32x4){lo16(nbb.x) * ncs, hi16(nbb.x) * ncs, lo16(nbb.y) * ncs, hi16(nbb.y) * ncs};
          *(f32x4*)(skp + lo) = (f32x4){lo16(nkp.x), hi16(nkp.x), lo16(nkp.y), hi16(nkp.y)};
          *(f32x4*)(srr + lo) = (f32x4){lo16(nrr.x), hi16(nrr.x), lo16(nrr.y), hi16(nrr.y)};
          *(u32x2*)(svv + lo) = nvv; }
        __syncthreads();
        if (blk + 1 < S_ / 32) { const size_t o = o0 + (size_t)(blk + 1) * 32 * 512;
            nld = *(const f32x4*)(((const float*)(C.ws + WS_RLD)) + o);
            nkk = *(const u32x2*)(((const bf16_t*)(C.ws + WS_RKK)) + o); nbb = *(const u32x2*)(((const bf16_t*)(C.ws + WS_RBB)) + o); nkp = *(const u32x2*)(((const bf16_t*)(C.ws + WS_RK)) + o);
            nrr = *(const u32x2*)(((const bf16_t*)(C.ws + WS_RR)) + o); nvv = *(const u32x2*)(((const bf16_t*)(C.ws + WS_RV)) + o);
            ncs = ((const float*)(C.ws + WS_RC))[(tb + 32 + lstep) * 8 + h]; }
#pragma unroll
        for (int tg = 0; tg < 2; ++tg) {
            float ykeep = 0.f;
#pragma unroll
            for (int tt = 0; tt < 16; ++tt) { const int t = 16 * tg + tt;
                const f32x4 dc = *(const f32x4*)(dec + t * 64 + 4 * kq), kk = *(const f32x4*)(skk + t * 64 + 4 * kq), bb = *(const f32x4*)(sbb + t * 64 + 4 * kq),
                            kp = *(const f32x4*)(skp + t * 64 + 4 * kq), rr = *(const f32x4*)(srr + t * 64 + 4 * kq);
                const float vr = bf2f(svv[t * 64 + row]);
                float sa = (s0 * kk[0] + s1 * kk[1]) + (s2 * kk[2] + s3 * kk[3]);
                const float t0_ = s0 * dc[0] + vr * kp[0], t1_ = s1 * dc[1] + vr * kp[1], t2_ = s2 * dc[2] + vr * kp[2], t3_ = s3 * dc[3] + vr * kp[3];
                sa = sum16(sa);
                s0 = t0_ - sa * bb[0]; s1 = t1_ - sa * bb[1]; s2 = t2_ - sa * bb[2]; s3 = t3_ - sa * bb[3];
                float y = (s0 * rr[0] + s1 * rr[1]) + (s2 * rr[2] + s3 * rr[3]);
                y = sum16(y);
                ykeep = (kq == tt) ? y : ykeep;
            }
            yb[(16 * tg + kq) * 32 + rloc] = ykeep;
        }
        __syncthreads();
        { const int st = tid >> 4, c2 = (tid & 15) * 2;
          float* yo = ((float*)(C.ws + WS_RY)) + (tb + st) * 512 + h * 64 + 32 * rh + c2;
          *(float2*)yo = *(const float2*)(yb + st * 32 + c2); }
    }
}
__device__ __forceinline__ void rwkv_finish(const Ctx& C, int l) {
    const int gw = C.bid * NWAVES + C.wave, NGW = C.G * NWAVES, lane = C.lane;
    const float* lng = C.in[IN_LNG] + l * 512; const float* lnb = C.in[IN_LNB] + l * 512;
    for (int t = gw; t < T_; t += NGW) {
        const float* yp = ((const float*)(C.ws + WS_RY)) + (size_t)t * 512 + 8 * lane;
        const f32x4 y0 = *(const f32x4*)yp, y1 = *(const f32x4*)(yp + 4);
        float sm = (y0[0] + y0[1] + y0[2] + y0[3]) + (y1[0] + y1[1] + y1[2] + y1[3]);
        sm = sum8(sm); const float mean = sm * (1.f / 64.f);
        float e[8];
#pragma unroll
        for (int i = 0; i < 4; ++i) { e[i] = y0[i] - mean; e[4 + i] = y1[i] - mean; }
        float vs = 0.f;
#pragma unroll
        for (int i = 0; i < 8; ++i) vs += e[i] * e[i];
        vs = sum8(vs); const float rstd = rsqrtf(vs * (1.f / 64.f) + 64e-5f);
        const float bon = ((const float*)(C.ws + WS_RBON))[(size_t)t * 8 + (lane >> 3)];
        const u32x4 uv = *(const u32x4*)(((const bf16_t*)(C.ws + WS_RV)) + (size_t)t * 512 + 8 * lane), ug = *(const u32x4*)(((const bf16_t*)(C.ws + WS_RG)) + (size_t)t * 512 + 8 * lane);
        float o[8];
#pragma unroll
        for (int i = 0; i < 4; ++i) { const int c = 8 * lane + 2 * i;
            o[2 * i] = (e[2 * i] * rstd * lng[c] + lnb[c] + bon * lo16(uv[i])) * lo16(ug[i]);
            o[2 * i + 1] = (e[2 * i + 1] * rstd * lng[c + 1] + lnb[c + 1] + bon * hi16(uv[i])) * hi16(ug[i]); }
        u32x4 w; w.x = pk2(o[0], o[1]); w.y = pk2(o[2], o[3]); w.z = pk2(o[4], o[5]); w.w = pk2(o[6], o[7]);
        *(u32x4*)(((bf16_t*)(C.ws + WS_OR)) + (size_t)t * 512 + 8 * lane) = w;
    }
}

constexpr int GL_BC = 0, GL_QT = 16896, GL_KT = 26112, GL_KHT = 35328, GL_VT = 44544, GL_ST = 62976, GL_PM = 81408, GL_OB = 90624, GL_GT = 124416, GL_LD = 72, GL_BS = 65;
__device__ __forceinline__ bf16x8 ldfrag(const LAS unsigned char* lds, int off, int row0, int k0, int lane) {
    return *(const LAS bf16x8*)(lds + off + ((row0 + (lane & 31)) * GL_LD + k0 + 8 * (lane >> 5)) * 2);
}
__device__ __forceinline__ void gla_wg(const Ctx& C0, int l, int bh) {
    Ctx C = C0; fresh(C);
    const int h = bh & 3, tid = C.tid, lane = C.lane, w = C.wave, r = lane & 31, hh = lane >> 5;
    float* Bc = (float*)(C.ldsg + GL_BC);
    bf16_t* Qt = (bf16_t*)(C.ldsg + GL_QT); bf16_t* Kt = (bf16_t*)(C.ldsg + GL_KT); bf16_t* KhT = (bf16_t*)(C.ldsg + GL_KHT);
    bf16_t* VTs = (bf16_t*)(C.ldsg + GL_VT); bf16_t* STs = (bf16_t*)(C.ldsg + GL_ST); bf16_t* Pm = (bf16_t*)(C.ldsg + GL_PM);
    float* Ob = (float*)(C.ldsg + GL_OB);
    float* Gt = (float*)(C.ldsg + GL_GT);
    for (int i = tid; i < 128 * GL_LD / 2; i += NTHR) ((unsigned*)STs)[i] = 0u;
    f32x16 st;
#pragma unroll
    for (int i = 0; i < 16; ++i) st[i] = 0.f;
    const float* gng = C.in[IN_GNG] + l * 128;
    const size_t hb = (size_t)bh * S_;
    const int bi = tid >> 3, e16 = (tid & 7) * 16;
    const int li = tid & 63, ld8 = (tid >> 6) * 8, le16 = (tid >> 6) * 16;
    const int pd = tid & 63, pg = tid >> 6;
    u32x4 nq = *(const u32x4*)(((const bf16_t*)(C.ws + WS_GQ)) + (hb + li) * 64 + ld8), nk = *(const u32x4*)(((const bf16_t*)(C.ws + WS_GK)) + (hb + li) * 64 + ld8);
    u32x4 nv0 = *(const u32x4*)(((const bf16_t*)(C.ws + WS_GV)) + (hb + li) * 128 + le16), nv1 = *(const u32x4*)(((const bf16_t*)(C.ws + WS_GV)) + (hb + li) * 128 + le16 + 8);
    float nla[8];
#pragma unroll
    for (int i = 0; i < 8; ++i) nla[i] = ((const float*)(C.ws + WS_LA))[(hb + 8 * pg + i) * 64 + pd];
    __syncthreads();
    for (int c = 0; c < S_ / 64; ++c) {
        const size_t tb = hb + c * 64;
        const u32x4 uq = nq, uk = nk, v0 = nv0, v1 = nv1;
        float lp[8]; { float run = 0.f;
#pragma unroll
            for (int i = 0; i < 8; ++i) { run += nla[i]; lp[i] = run; }
            Gt[pg * 64 + pd] = run; }
        const u32x4 g0 = *(const u32x4*)(((const bf16_t*)(C.ws + WS_GG)) + (tb + bi) * 128 + e16), g1 = *(const u32x4*)(((const bf16_t*)(C.ws + WS_GG)) + (tb + bi) * 128 + e16 + 8);
        if (c + 1 < S_ / 64) { const size_t tn = tb + 64;
            nq = *(const u32x4*)(((const bf16_t*)(C.ws + WS_GQ)) + (tn + li) * 64 + ld8); nk = *(const u32x4*)(((const bf16_t*)(C.ws + WS_GK)) + (tn + li) * 64 + ld8);
            nv0 = *(const u32x4*)(((const bf16_t*)(C.ws + WS_GV)) + (tn + li) * 128 + le16); nv1 = *(const u32x4*)(((const bf16_t*)(C.ws + WS_GV)) + (tn + li) * 128 + le16 + 8);
#pragma unroll
            for (int i = 0; i < 8; ++i) nla[i] = ((const float*)(C.ws + WS_LA))[(tn + 8 * pg + i) * 64 + pd]; }
        __syncthreads();
        { float off = 0.f;
#pragma unroll
          for (int g = 0; g < 7; ++g) off += (g < pg) ? Gt[g * 64 + pd] : 0.f;
#pragma unroll
          for (int i = 0; i < 8; ++i) Bc[(8 * pg + i) * GL_BS + pd] = off + lp[i]; }
        __syncthreads();
        { const int i = li, d8 = ld8, e16b = le16;
          float q[8], k[8];
#pragma unroll
          for (int e = 0; e < 4; ++e) { q[2 * e] = lo16(uq[e]); q[2 * e + 1] = hi16(uq[e]); k[2 * e] = lo16(uk[e]); k[2 * e + 1] = hi16(uk[e]); }
          float qt[8], kt[8];
#pragma unroll
          for (int e = 0; e < 8; ++e) { const float bb = Bc[i * GL_BS + d8 + e], bl = Bc[63 * GL_BS + d8 + e];
              qt[e] = q[e] * 0.125f * __expf(bb); kt[e] = k[e] * __expf(-bb); KhT[(d8 + e) * GL_LD + i] = f2bf(k[e] * __expf(bl - bb)); }
          u32x4 wq, wk;
#pragma unroll
          for (int e = 0; e < 4; ++e) { wq[e] = pk2(qt[2 * e], qt[2 * e + 1]); wk[e] = pk2(kt[2 * e], kt[2 * e + 1]); }
          *(u32x4*)(Qt + i * GL_LD + d8) = wq; *(u32x4*)(Kt + i * GL_LD + d8) = wk;
#pragma unroll
          for (int e = 0; e < 4; ++e) { VTs[(e16b + 2 * e) * GL_LD + i] = (bf16_t)(v0[e] & 0xffffu); VTs[(e16b + 2 * e + 1) * GL_LD + i] = (bf16_t)(v0[e] >> 16);
              VTs[(e16b + 8 + 2 * e) * GL_LD + i] = (bf16_t)(v1[e] & 0xffffu); VTs[(e16b + 8 + 2 * e + 1) * GL_LD + i] = (bf16_t)(v1[e] >> 16); } }
        __syncthreads();
        if (w < 4) { const int ti = w >> 1, tj = w & 1; f32x16 a;
#pragma unroll
            for (int i = 0; i < 16; ++i) a[i] = 0.f;
            if (!(ti == 0 && tj == 1)) {
#pragma unroll
                for (int s = 0; s < 4; ++s) a = MFMA32(ldfrag(C.lds, GL_QT, 32 * ti, 16 * s, lane), ldfrag(C.lds, GL_KT, 32 * tj, 16 * s, lane), a); }
#pragma unroll
            for (int i = 0; i < 16; ++i) { const int ii = 32 * ti + crow(i, hh), jj = 32 * tj + r; Pm[ii * GL_LD + jj] = f2bf(jj <= ii ? a[i] : 0.f); } }
        { const int te = w >> 1, td = w & 1; const float dl = __expf(Bc[63 * GL_BS + 32 * td + r]);
#pragma unroll
          for (int i = 0; i < 16; ++i) st[i] *= dl;
#pragma unroll
          for (int s = 0; s < 4; ++s) st = MFMA32(ldfrag(C.lds, GL_VT, 32 * te, 16 * s, lane), ldfrag(C.lds, GL_KHT, 32 * td, 16 * s, lane), st); }
        __syncthreads();
        { const int ti = w >> 2, te = w & 3; f32x16 a;
#pragma unroll
          for (int i = 0; i < 16; ++i) a[i] = 0.f;
#pragma unroll
          for (int s = 0; s < 4; ++s) a = MFMA32(ldfrag(C.lds, GL_PM, 32 * ti, 16 * s, lane), ldfrag(C.lds, GL_VT, 32 * te, 16 * s, lane), a);
#pragma unroll
          for (int s = 0; s < 4; ++s) a = MFMA32(ldfrag(C.lds, GL_QT, 32 * ti, 16 * s, lane), ldfrag(C.lds, GL_ST, 32 * te, 16 * s, lane), a);
#pragma unroll
          for (int i = 0; i < 16; ++i) Ob[(32 * ti + crow(i, hh)) * 132 + 32 * te + r] = a[i]; }
        __syncthreads();
        { const int te = w >> 1, td = w & 1;
#pragma unroll
          for (int i = 0; i < 16; ++i) STs[(32 * te + crow(i, hh)) * GL_LD + 32 * td + r] = f2bf(st[i]); }
        { const int i = bi; float o[16]; float ss = 0.f;
#pragma unroll
          for (int q = 0; q < 4; ++q) { const f32x4 x = *(const f32x4*)(Ob + i * 132 + e16 + 4 * q); o[4 * q] = x[0]; o[4 * q + 1] = x[1]; o[4 * q + 2] = x[2]; o[4 * q + 3] = x[3]; ss += x[0] * x[0] + x[1] * x[1] + x[2] * x[2] + x[3] * x[3]; }
          ss = sum8(ss);
          const float rstd = rsqrtf(ss * (1.f / 128.f) + 1e-6f);
          float gt[16];
#pragma unroll
          for (int e = 0; e < 4; ++e) { gt[2 * e] = lo16(g0[e]); gt[2 * e + 1] = hi16(g0[e]); gt[8 + 2 * e] = lo16(g1[e]); gt[8 + 2 * e + 1] = hi16(g1[e]); }
#pragma unroll
          for (int e = 0; e < 16; ++e) o[e] = o[e] * rstd * gng[e16 + e] * siluf_(gt[e]);
          u32x4 w0, w1;
#pragma unroll
          for (int e = 0; e < 4; ++e) { w0[e] = pk2(o[2 * e], o[2 * e + 1]); w1[e] = pk2(o[8 + 2 * e], o[8 + 2 * e + 1]); }
          bf16_t* dst = ((bf16_t*)(C.ws + WS_OG)) + ((size_t)(bh >> 2) * S_ + c * 64 + i) * 512 + h * 128 + e16;
          *(u32x4*)dst = w0; *(u32x4*)(dst + 8) = w1; }
        __syncthreads();
    }
}

constexpr int AT_Q = 0, AT_K = 65536, AT_V = 65536 + 18432, AT_KLD = 72, AT_VLD = 36;
__device__ __forceinline__ void attn_wg(const Ctx& C0, int l, int bh, int jb, float lam, float lam_init) {
    Ctx C = C0; fresh(C);
    const int b = bh >> 2, h = bh & 3, tid = C.tid, lane = C.lane, r = lane & 31, hh = lane >> 5, j = 8 * jb + C.wave;
    LAS bf16x8* qs = (LAS bf16x8*)(C.lds + AT_Q + C.wave * 8192) + lane;
#pragma unroll
    for (int cc = 0; cc < 2; ++cc)
#pragma unroll
        for (int s = 0; s < 4; ++s) qs[64 * (cc * 4 + s)] = *(const bf16x8*)(((const bf16_t*)(C.ws + WS_QH)) + (((size_t)b * 8 + h * 2 + cc) * S_ + 32 * j + r) * 64 + 16 * s + 8 * hh);
    f32x16 O[2][4];
#pragma unroll
    for (int cc = 0; cc < 2; ++cc)
#pragma unroll
        for (int k = 0; k < 4; ++k)
#pragma unroll
            for (int i = 0; i < 16; ++i) O[cc][k][i] = 0.f;
    float mrun[2] = {-INFINITY, -INFINITY}, lsum[2] = {0.f, 0.f};
    const float slope = exp2f(-2.f * (float)(h + 1));
    const int qpos = 32 * j + r;
    const int kcc = tid >> 8, kkey = (tid >> 3) & 31, kc = tid & 7, ve = tid >> 2, vc = tid & 3;
    const bf16_t* kg = ((const bf16_t*)(C.ws + WS_KH)) + (((size_t)b * 8 + h * 2 + kcc) * S_ + kkey) * 64 + 8 * kc;
    const bf16_t* vg = ((const bf16_t*)(C.ws + WS_VT)) + (((size_t)b * 4 + h) * 64) * 4096 + ve * 32 + 8 * vc;
    const int klo = AT_K + ((kcc * 32 + kkey) * AT_KLD + 8 * kc) * 2, vlo = AT_V + (ve * AT_VLD + 8 * vc) * 2;
    const int ntiles = 8 * jb + 8;
    u32x4 kreg = *(const u32x4*)kg, vreg = *(const u32x4*)vg;
    for (int kt = 0; kt < ntiles; ++kt) {
        const int boff = (kt & 1) * 9216;
        *(LAS u32x4*)(C.lds + klo + boff) = kreg;
        { LAS u32x2* vd = (LAS u32x2*)(C.lds + vlo + boff); u32x2 a, c2; a.x = vreg.x; a.y = vreg.y; c2.x = vreg.z; c2.y = vreg.w; vd[0] = a; vd[1] = c2; }
        if (kt + 1 < ntiles) { kreg = *(const u32x4*)(kg + (size_t)(kt + 1) * 32 * 64); vreg = *(const u32x4*)(vg + (size_t)(kt + 1) * 4096); }
        __syncthreads();
        if (kt <= j) {
            const LAS unsigned char* kb = C.lds + AT_K + boff; const LAS unsigned char* vb = C.lds + AT_V + boff;
#pragma unroll
            for (int cc = 0; cc < 2; ++cc) {
                f32x16 sc;
#pragma unroll
                for (int i = 0; i < 16; ++i) sc[i] = 0.f;
#pragma unroll
                for (int s = 0; s < 4; ++s) { const bf16x8 kf = *(const LAS bf16x8*)(kb + ((cc * 32 + r) * AT_KLD + 16 * s + 8 * hh) * 2); sc = MFMA32(kf, qs[64 * (cc * 4 + s)], sc); }
                float mx = -INFINITY;
#pragma unroll
                for (int i = 0; i < 16; ++i) { const int dist = qpos - (32 * kt + crow(i, hh)); float v = sc[i] - slope * (float)dist; v = (dist < 0) ? -INFINITY : v; sc[i] = v; mx = fmaxf(mx, v); }
                mx = fmaxf(mx, xor32(mx, lane));
                const float mnew = fmaxf(mrun[cc], mx);
                float ps = 0.f;
#pragma unroll
                for (int i = 0; i < 16; ++i) { const float p = __expf(sc[i] - mnew); sc[i] = p; ps += p; }
                ps += xor32(ps, lane);
                if (__any(mnew > mrun[cc])) {
                    const float alpha = __expf(mrun[cc] - mnew);
                    lsum[cc] *= alpha;
#pragma unroll
                    for (int k = 0; k < 4; ++k)
#pragma unroll
                        for (int i = 0; i < 16; ++i) O[cc][k][i] *= alpha;
                }
                lsum[cc] += ps; mrun[cc] = mnew;
                bf16x8 pb[2];
#pragma unroll
                for (int s2 = 0; s2 < 2; ++s2) { u32x4 t; t.x = pk2(sc[8 * s2], sc[8 * s2 + 1]); t.y = pk2(sc[8 * s2 + 2], sc[8 * s2 + 3]); t.z = pk2(sc[8 * s2 + 4], sc[8 * s2 + 5]); t.w = pk2(sc[8 * s2 + 6], sc[8 * s2 + 7]); pb[s2] = __builtin_bit_cast(bf16x8, t); }
#pragma unroll
                for (int k = 0; k < 4; ++k)
#pragma unroll
                    for (int s2 = 0; s2 < 2; ++s2) { const LAS unsigned char* vp = vb + ((32 * k + r) * AT_VLD + 16 * s2 + 4 * hh) * 2;
                        const u32x2 lo = *(const LAS u32x2*)vp, hi = *(const LAS u32x2*)(vp + 16);
                        u32x4 t; t.x = lo.x; t.y = lo.y; t.z = hi.x; t.w = hi.y;
                        O[cc][k] = MFMA32(__builtin_bit_cast(bf16x8, t), pb[s2], O[cc][k]); }
                __builtin_amdgcn_sched_barrier(0);
            }
        }
    }
    const float i1 = 1.f / lsum[0], i2 = lam / lsum[1];
    float ss = 0.f;
#pragma unroll
    for (int k = 0; k < 4; ++k)
#pragma unroll
        for (int i = 0; i < 16; ++i) { const float o = O[0][k][i] * i1 - O[1][k][i] * i2; O[0][k][i] = o; ss += o * o; }
    ss += xor32(ss, lane);
    const float rs = rsqrtf(ss * (1.f / 128.f) + 1e-6f) * (1.f - lam_init);
    const float* sg = C.in[IN_SUBLN] + l * 128;
    bf16_t* dst = ((bf16_t*)(C.ws + WS_OA)) + (size_t)(b * S_ + 32 * j + r) * 512 + h * 128;
#pragma unroll
    for (int k = 0; k < 4; ++k)
#pragma unroll
        for (int g = 0; g < 4; ++g) { const int dv = 32 * k + 8 * g + 4 * hh; const f32x4 gg = *(const f32x4*)(sg + dv);
            u32x2 w; w.x = pk2(O[0][k][4 * g] * rs * gg[0], O[0][k][4 * g + 1] * rs * gg[1]); w.y = pk2(O[0][k][4 * g + 2] * rs * gg[2], O[0][k][4 * g + 3] * rs * gg[3]);
            *(u32x2*)(dst + dv) = w; }
    __syncthreads();
}

__device__ __forceinline__ void gate_units(const Ctx& C0, int l) {
    Ctx C = C0; fresh(C);
    __syncthreads();
    GateOrder S; S.A = (const char*)(C.ws + WS_H); S.B = (const char*)(((const bf16_t*)(C.ws + WS_WIN)) + (size_t)l * NP_ * 1024); { const int a = C.bid - 128; S.q = (a & 7) * 16 + (a >> 3); }
    EpiP E{C.ws};
    pg8::gemm_phase<EpiP, GateOrder, false>(C.lds, C.tid, 1024, 2048u, 2048u, S, E);
}
__device__ __forceinline__ void phase_mixers(const Ctx& C, int l) {
#ifndef REP_R
#define REP_R 1
#define REP_G 1
#define REP_A 1
#endif
    if (C.bid < 128) { for (int rep = 0; rep < REP_R; ++rep) rwkv_wg(C, l, C.bid); return; }
    if (C.bid < 160) { for (int rep = 0; rep < REP_G; ++rep) gla_wg(C, l, C.bid - 128); gate_units(C, l); return; }
    const float lam_init = 0.8f - 0.6f * __expf(-0.3f * (float)l);
    const float* lv = C.in[IN_LAM] + l * 256;
    const float d0 = wave_sum(lv[C.lane] * lv[64 + C.lane]), d1 = wave_sum(lv[128 + C.lane] * lv[192 + C.lane]);
    const float lam = __expf(d0) - __expf(d1) + lam_init;
    {
        const int a = C.bid - 160, grp = a >> 5, bh = a & 31;
        for (int rep = 0; rep < REP_A; ++rep) {
            if (grp == 0) { attn_wg(C, l, bh, 7, lam, lam_init); attn_wg(C, l, bh, 3, lam, lam_init); }
            else if (grp == 1) { attn_wg(C, l, bh, 6, lam, lam_init); attn_wg(C, l, bh, 4, lam, lam_init); }
            else { attn_wg(C, l, bh, 5, lam, lam_init); attn_wg(C, l, bh, 2, lam, lam_init); attn_wg(C, l, bh, 1, lam, lam_init); attn_wg(C, l, bh, 0, lam, lam_init); }
        }
    }
    gate_units(C, l);
}

__device__ __forceinline__ int rcount_of(int wave, int bid, int G) { const int gw = bid * NWAVES + wave, NGW = G * NWAVES; return gw < T_ ? (T_ - 1 - gw) / NGW + 1 : 0; }
__device__ __forceinline__ void phase_route(const Ctx& C, int l) {
    float* rw = (float*)C.ldsg;
    { const float* gw_ = C.in[IN_RGW] + (size_t)l * 1024 * 4; const float* ew = C.in[IN_REW] + (size_t)l * 1024 * 32;
#pragma unroll 8
      for (int i = C.tid; i < 1024 * 8; i += NTHR) { const int k = i >> 3, o4 = (i & 7) * 4; *(f32x4*)(rw + k * 36 + 4 + o4) = *(const f32x4*)(ew + 4 * i); }
#pragma unroll
      for (int i = C.tid; i < 1024; i += NTHR) *(f32x4*)(rw + i * 36) = *(const f32x4*)(gw_ + 4 * i); }
    __syncthreads();
    const int gw = C.bid * NWAVES + C.wave, NGW = C.G * NWAVES, lane = C.lane;
    int* rr_e = (int*)(C.ldsg + 147456); float* rr_w = (float*)(C.ldsg + 147456 + 512); int* rr_t = (int*)(C.ldsg + 147456 + 1024);
    int* lcnt = (int*)(C.ldsg + 147456 + 1280); int* lbase = (int*)(C.ldsg + 147456 + 1408);
    float* gmv = (float*)(C.ldsg + 149504); float* shv = gmv + 1024;
    int rcount = 0;
    for (int slab = C.bid; slab < T_ / 64; slab += C.G) {
        const int b = (64 * slab) >> 11; const float* md = ((float*)(C.ws + WS_MOD)) + ((size_t)l * 8 + b) * 6144;
        __syncthreads();
        for (int k = C.tid; k < 1024; k += NTHR) { gmv[k] = C.in[IN_N2G][l * 1024 + k] * (1.f + md[4096 + k]); shv[k] = md[3072 + k]; }
        __syncthreads();
#pragma unroll 1
      for (int rw8 = 0; rw8 < 8; ++rw8) {
        const int t = 64 * slab + 8 * C.wave + rw8; const float* xr = C.out + (size_t)t * 1024;
        float ss = 0.f;
#pragma unroll
        for (int i = 0; i < 16; ++i) { const float xv = xr[lane + 64 * i]; ss += xv * xv; }
        ss = wave_sum(ss);
        const float rstd = rsqrtf(ss * (1.f / 1024.f) + 1e-6f);
        float acc[36];
#pragma unroll
        for (int o = 0; o < 36; ++o) acc[o] = 0.f;
        float n0 = xr[lane], n1 = xr[lane + 64];
#pragma unroll 1
        for (int i = (C.flags & 4) ? 16 : 0; i < 16; i += 2) {
            const float c0 = n0, c1 = n1;
            if (i + 2 < 16) { n0 = xr[lane + 64 * (i + 2)]; n1 = xr[lane + 64 * (i + 3)]; }
#pragma unroll
            for (int u = 0; u < 2; ++u) { const int k = lane + 64 * (i + u);
                const float h2 = (u ? c1 : c0) * rstd * gmv[k] + shv[k];
                ((bf16_t*)(C.ws + WS_H))[(size_t)t * 1024 + k] = f2bf(h2);
                const float* wr_ = rw + k * 36;
#pragma unroll
                for (int q = 0; q < 9; ++q) { const f32x4 wv = *(const f32x4*)(wr_ + 4 * q); acc[4 * q] += h2 * wv[0]; acc[4 * q + 1] += h2 * wv[1]; acc[4 * q + 2] += h2 * wv[2]; acc[4 * q + 3] += h2 * wv[3]; } }
        }
        int grp = 0, i0 = 0, i1 = 1; float w0 = 0.f, w1 = 0.f;
        if (!(C.flags & 8)) {
#pragma unroll
        for (int o = 0; o < 36; ++o) acc[o] = wave_sum(acc[o]) + ((o < 4) ? C.in[IN_RGB][l * 4 + o] : C.in[IN_REB][l * 32 + o - 4]);
        grp = 0; float gm = acc[0];
#pragma unroll
        for (int g = 1; g < 4; ++g) if (acc[g] > gm) { gm = acc[g]; grp = g; }
        float gsum = 0.f;
#pragma unroll
        for (int g = 0; g < 4; ++g) gsum += __expf(acc[g] - gm);
        const float gprob = 1.f / gsum;
        float ev[8];
        const float mg0 = (grp == 0) ? 1.f : 0.f, mg1 = (grp == 1) ? 1.f : 0.f, mg2 = (grp == 2) ? 1.f : 0.f, mg3 = (grp == 3) ? 1.f : 0.f;
#pragma unroll
        for (int e = 0; e < 8; ++e) ev[e] = mg0 * acc[4 + e] + mg1 * acc[12 + e] + mg2 * acc[20 + e] + mg3 * acc[28 + e];
        i0 = 0; float v0 = ev[0];
#pragma unroll
        for (int e = 1; e < 8; ++e) if (ev[e] > v0) { v0 = ev[e]; i0 = e; }
        i1 = -1; float v1 = -INFINITY;
#pragma unroll
        for (int e = 0; e < 8; ++e) if (e != i0 && ev[e] > v1) { v1 = ev[e]; i1 = e; }
        const float e1 = __expf(v1 - v0), den = 1.f / (1.f + e1);
        w0 = gprob * den; w1 = gprob * e1 * den;
        }
        if (lane == 0) {
            const int ri = C.wave * 8 + rcount;
            rr_e[2 * ri] = grp * 8 + i0; rr_e[2 * ri + 1] = grp * 8 + i1; rr_w[2 * ri] = w0; rr_w[2 * ri + 1] = w1; rr_t[ri] = t;
        }
        ++rcount;
      }
    }
    __syncthreads();
    if (C.tid < 32) lcnt[C.tid] = 0;
    __syncthreads();
    int my_e = -1, my_lp = 0, my_slot = 0; float my_w = 0.f;
    if (C.tid < 128 && !(C.flags & 1)) { const int ri = C.tid >> 1, k = C.tid & 1;
        if ((ri & 7) < rcount) { my_e = rr_e[C.tid]; my_w = rr_w[C.tid]; my_slot = 2 * rr_t[ri] + k; my_lp = atomicAdd(&lcnt[my_e], 1); } }
    __syncthreads();
    if (C.tid < 32) { const int n = lcnt[C.tid]; lbase[C.tid] = n ? (int)atomicAdd(((unsigned*)(C.ws + WS_CTL)) + CW_CNT + l * 2048 + 64 * C.tid, (unsigned)n) : 0; }
    __syncthreads();
    if (my_e >= 0) { const size_t o = (size_t)my_e * ECAP + lbase[my_e] + my_lp; ((int*)(C.ws + WS_LIST))[o] = my_slot; ((float*)(C.ws + WS_WL))[o] = my_w; }
    __syncthreads();
    LAS float* scr = (LAS float*)(C.lds + C.wave * 8448);
    constexpr int I_GU = 32 * 16 * 32, I_DN = 32 * 8 * 32;
    for (int it = (C.flags & 2) ? I_GU + I_DN : gw; it < I_GU + I_DN; it += NGW) {
        if (it < I_GU) { const int e = it / 512, q = it % 512, kb = q / 32, nb = q % 32, n0 = 32 * nb;
            const int up = (n0 >> 7) & 1, col = (n0 >> 8) * 128 + (n0 & 127);
            const float* src = C.in[up ? IN_EU : IN_EG] + ((size_t)(l * 32 + e) * 1024 + 64 * kb) * 512;
            transpose_item(src, 512, col, 32, ((bf16_t*)(C.ws + WS_WGU)) + (size_t)e * 1024 * 1024, 1024, n0, 64 * kb, scr, lane);
        } else { const int r = it - I_GU, e = r / 256, q = r % 256, kb = q / 32, nb = q % 32;
            const float* src = C.in[IN_ED] + ((size_t)(l * 32 + e) * 512 + 64 * kb) * 1024;
            transpose_item(src, 1024, 32 * nb, 32, ((bf16_t*)(C.ws + WS_WD)) + (size_t)e * 1024 * 512, 512, 32 * nb, 64 * kb, scr, lane); }
    }
}
constexpr int NPHASE = 22;
#ifndef PHMASK
#define PHMASK 0x7ff
#endif
#define EN(n) ((PHMASK >> (n)) & 1)
#define IN(k) (lo <= (k) && (k) < hi)
#ifndef XBAR_REP
#define XBAR_REP 1
#endif
#define SEAM(k) do { if (IN((k) + 1)) for (int xb_ = 0; xb_ < XBAR_REP; ++xb_) xcd_barrier(bar); } while (0)
#ifndef REP_PRO
#define REP_PRO 1
#define REP_WIN 1
#define REP_MRG 1
#define REP_UP 1
#define REP_DN 1
#define REP_ROW0 1
#endif
template <int L> __device__ __forceinline__ void run_layer(Ctx& C, const int lo, const int hi, const XcdBarrier& bar) {
    const int l = L;
        const int pb = 1 + 10 * l;
        if (EN(1) && IN(pb + 0)) { fresh(C); phase_rows(C, l, (l > 0 ? 1 : 0) | 2); if (l == 0) for (int rep = 1; rep < REP_ROW0; ++rep) phase_rows(C, l, 2); SEAM(pb + 0); }
        if (EN(2) && IN(pb + 1)) { fresh(C);
            WinOrder S; S.A = (const char*)(C.ws + WS_H); S.B = (const char*)(((const bf16_t*)(C.ws + WS_WIN)) + (size_t)l * NP_ * 1024); S.G = C.G; S.c = C.bid;
            EpiP E{C.ws};
            for (int rep = 0; rep < REP_WIN; ++rep) pg8::gemm_phase<EpiP, WinOrder, false>(C.lds, C.tid, 1024, 2048u, 2048u, S, E);
            SEAM(pb + 1);
        }
        if (EN(3) && IN(pb + 2)) { fresh(C); phase_prep(C, l); SEAM(pb + 2); }
        if (EN(4) && IN(pb + 3)) { fresh(C); phase_mixers(C, l); SEAM(pb + 3); }
        if (EN(5) && IN(pb + 4)) { fresh(C); rwkv_finish(C, l); SEAM(pb + 4); }
        if (EN(6) && IN(pb + 5)) { fresh(C);
            MergeOrder S; S.O0 = ((bf16_t*)(C.ws + WS_OA)); S.O1 = ((bf16_t*)(C.ws + WS_OR)); S.O2 = ((bf16_t*)(C.ws + WS_OG)); S.W = ((bf16_t*)(C.ws + WS_WPROJ)) + (size_t)l * 3 * 1024 * 512; S.G = C.G; S.c = C.vcu;
            EpiMerge E{((bf16_t*)(C.ws + WS_GATES)), ((bf16_t*)(C.ws + WS_H))};
            for (int rep = 0; rep < REP_MRG; ++rep) pg8::gemm_phase<EpiMerge, MergeOrder, false>(C.lds, C.tid, 512, 1024u, 1024u, S, E);
            SEAM(pb + 5);
        }
        if (EN(7) && IN(pb + 6)) { fresh(C);
            pg8::DenseOrder S; S.init(((bf16_t*)(C.ws + WS_H)), ((bf16_t*)(C.ws + WS_WOUT)) + (size_t)l * 1024 * 1024, 2048u, 2048u, T_, 1024, C.G, C.bid);
            EpiOut E{l == 0 ? C.in[IN_X] : C.out, C.out, ((float*)(C.ws + WS_MOD)) + (size_t)l * 8 * 6144 + 2048};
            pg8::gemm_phase<EpiOut, pg8::DenseOrder, false>(C.lds, C.tid, 1024, 2048u, 2048u, S, E);
            SEAM(pb + 6);
        }
        if (EN(8) && IN(pb + 7)) { fresh(C); phase_route(C, l); SEAM(pb + 7); }
        if (EN(9) && IN(pb + 8)) { fresh(C);
            moe_build_table(C, l);
            MoeOrder S; S.tab = (const LAS int*)(C.lds + LDS_SCHED); S.A = (const char*)((bf16_t*)(C.ws + WS_H)); S.B = (const char*)((bf16_t*)(C.ws + WS_WGU)); S.LIST = ((int*)(C.ws + WS_LIST)); S.WL = ((float*)(C.ws + WS_WL)); S.G = C.G; S.c = C.vcu; S.down = 0;
            EpiHid E{((bf16_t*)(C.ws + WS_HID))};
            for (int rep = 0; rep < REP_UP; ++rep) pg8::gemm_phase<EpiHid, MoeOrder, true>(C.lds, C.tid, 1024, 2048u, 2048u, S, E);
            SEAM(pb + 8);
        }
        if (EN(10) && IN(pb + 9)) { fresh(C);
            moe_build_table(C, l);
            MoeOrder S; S.tab = (const LAS int*)(C.lds + LDS_SCHED); S.A = (const char*)((bf16_t*)(C.ws + WS_HID)); S.B = (const char*)((bf16_t*)(C.ws + WS_WD)); S.LIST = ((int*)(C.ws + WS_LIST)); S.WL = ((float*)(C.ws + WS_WL)); S.G = C.G; S.c = C.vcu; S.down = 1;
            EpiDown E{((bf16_t*)(C.ws + WS_YS))};
            for (int rep = 0; rep < REP_DN; ++rep) pg8::gemm_phase<EpiDown, MoeOrder, false>(C.lds, C.tid, 512, 1024u, 1024u, S, E);
            SEAM(pb + 9);
        }
    }
__global__ void __launch_bounds__(NTHR, 2) hybrid_fwd(Args args) {
    extern __shared__ __attribute__((aligned(16))) unsigned char lds_raw[];
    Ctx C;
    C.in = args.in; C.out = args.out; C.ws = args.ws; C.ws0 = args.ws;
    C.ldsg = lds_raw; C.lds = (LAS unsigned char*)lds_raw;
    C.flags = args.flags; C.tid = threadIdx.x; C.lane = C.tid & 63; C.wave = __builtin_amdgcn_readfirstlane(C.tid >> 6); C.G = gridDim.x; C.bid = blockIdx.x;
    C.vcu = (C.G % 8 == 0) ? (C.bid % 8) * (C.G / 8) + C.bid / 8 : C.bid;
    volatile LAS unsigned* bst = (volatile LAS unsigned*)(C.lds + LDS_CTL);
    if (C.tid < 4) bst[C.tid] = 0u;
    __syncthreads();
    const int lo = args.ph_lo, hi = args.ph_hi;
    const bool multi = (hi - lo) > 1;
    XcdBarrier bar; bar.bar = ((unsigned*)(C.ws + WS_CTL)) + CW_BAR; bar.x = 0; bar.st = bst;
    if (multi) bar = xcd_barrier_post(((unsigned*)(C.ws + WS_CTL)) + CW_BAR, bst);

    if (EN(0) && IN(0)) { fresh(C); for (int rep = 0; rep < REP_PRO; ++rep) phase_prologue(C); SEAM(0); }
    run_layer<0>(C, lo, hi, bar);
    run_layer<1>(C, lo, hi, bar);
    if (IN(21)) { fresh(C); phase_rows(C, 2, 1); }
}

#ifndef N_LAUNCH_MODE
#define N_LAUNCH_MODE 1
#endif
extern "C" void kernel_launch(void* const* d_in, const int* in_sizes, int n_in, void* d_out, int out_size, void* d_ws, size_t ws_size, hipStream_t stream) {
    static int grid = 0;
    if (grid == 0) {
        if (n_in != 36 || out_size != T_ * D_ || ws_size < WS_END) { fprintf(stderr, "kernel_launch: unexpected problem (n_in %d, out %d, ws %zu < %zu)\n", n_in, out_size, ws_size, (size_t)WS_END); grid = -1; return; }
        int dev = 0, cus = 0, per_cu = 0;
        if (hipGetDevice(&dev) != hipSuccess || hipDeviceGetAttribute(&cus, hipDeviceAttributeMultiprocessorCount, dev) != hipSuccess) { grid = -1; return; }
        if (hipFuncSetAttribute((const void*)hybrid_fwd, hipFuncAttributeMaxDynamicSharedMemorySize, LDS_BYTES) != hipSuccess) { fprintf(stderr, "kernel_launch: hipFuncSetAttribute failed\n"); grid = -1; return; }
        if (hipOccupancyMaxActiveBlocksPerMultiprocessor(&per_cu, (const void*)hybrid_fwd, NTHR, LDS_BYTES) != hipSuccess || per_cu < 1) fprintf(stderr, "kernel_launch: occupancy query says %d\n", per_cu);
        (void)hipGetLastError();
        if (cus < 256) { fprintf(stderr, "kernel_launch: needs 256 CUs, device has %d\n", cus); grid = -1; return; }
        grid = 256;
    }
    if (grid < 0) return;
    (void)hipMemsetAsync((char*)d_ws + WS_CTL, 0, CTL_BYTES, stream);
    Args a{};
    for (int i = 0; i < 36; ++i) a.in[i] = (const float*)d_in[i];
    a.out = (float*)d_out; a.ws = (unsigned char*)d_ws;
#if N_LAUNCH_MODE == 1
    a.ph_lo = 0; a.ph_hi = NPHASE;
    hipLaunchKernelGGL(hybrid_fwd, dim3(grid), dim3(NTHR), LDS_BYTES, stream, a);
#else
#ifndef HREP_LIST
#define HREP_LIST 1,1,1,1,1,1,1,1,1,1,1,1,1,1,1,1,1,1,1,1,1,1
#endif
    static const int hrep[NPHASE] = {HREP_LIST};
#ifndef HREP_FLAGS
#define HREP_FLAGS 3
#endif
    for (int p = 0; p < NPHASE; ++p) for (int r = 0; r < hrep[p]; ++r) { a.ph_lo = p; a.ph_hi = p + 1; a.flags = r ? HREP_FLAGS : 0; hipLaunchKernelGGL(hybrid_fwd, dim3(grid), dim3(NTHR), LDS_BYTES, stream, a); }
#endif
}
```

```cpp
#include <hip/hip_runtime.h>
#include <cstdio>
#include <cstdint>

#define LAS __attribute__((address_space(3)))
typedef unsigned short bf16_t;
typedef short bf16x8 __attribute__((ext_vector_type(8)));
typedef float f32x4 __attribute__((ext_vector_type(4)));
typedef float f32x16 __attribute__((ext_vector_type(16)));
typedef unsigned u32x4 __attribute__((ext_vector_type(4)));
typedef unsigned u32x2 __attribute__((ext_vector_type(2)));

constexpr int T_ = 16384, D_ = 1024, S_ = 2048, NB_ = 8, NP_ = 8192, NIN_ = 7952;
constexpr int ECAP = 16384;
constexpr int NWAVES = 8, NTHR = 512;
constexpr int LDS_BYTES = 163840, LDS_CTL = LDS_BYTES - 256, LDS_SCHED = 131072;

constexpr size_t MiB = 1u << 20;
constexpr size_t WS_CTL = 0, CTL_BYTES = 256 * 1024;
constexpr size_t WS_MOD = 1 * MiB, WS_LW = WS_MOD + 512 * 1024;
constexpr size_t WS_WIN = 2 * MiB, WS_WPROJ = 34 * MiB, WS_WOUT = 40 * MiB;
constexpr size_t WS_H = 44 * MiB, WS_OA = 76 * MiB, WS_OR = 92 * MiB, WS_OG = 108 * MiB, WS_VT = 124 * MiB;
constexpr size_t WS_RR = 140 * MiB, WS_RK = 156 * MiB, WS_RV = 172 * MiB, WS_RKK = 188 * MiB, WS_RBB = 204 * MiB, WS_RG = 220 * MiB, WS_RLD = 236 * MiB, WS_RBON = 268 * MiB;
constexpr size_t WS_LA = 270 * MiB, WS_P = 286 * MiB;
constexpr size_t WS_QH = WS_P, WS_KH = WS_P + 16 * MiB, WS_AV = WS_P + 32 * MiB, WS_RWS = WS_P + 48 * MiB, WS_GQ = WS_P + 104 * MiB, WS_GK = WS_P + 112 * MiB, WS_GV = WS_P + 120 * MiB, WS_GG = WS_P + 136 * MiB,
                 WS_GATES = WS_P + 152 * MiB, WS_GAD = WS_P + 248 * MiB;
constexpr size_t WS_RC = WS_RBON + 1 * MiB;
constexpr size_t WS_RY = WS_RWS;
constexpr size_t WS_WGU = WS_P, WS_WD = WS_P + 64 * MiB, WS_HID = WS_P + 96 * MiB, WS_YS = WS_P + 136 * MiB, WS_LIST = WS_P + 200 * MiB, WS_WL = WS_P + 202 * MiB;
constexpr size_t WS_END = WS_P + 256 * MiB;
constexpr int CW_BAR = 4096, CW_CNT = 16384, CW_TD = 32768;
constexpr int CW_DUMMY_ = 0;

__device__ __forceinline__ float bf2f(bf16_t v) { return __uint_as_float(((unsigned)v) << 16); }
__device__ __forceinline__ bf16_t f2bf(float f) { return __builtin_bit_cast(unsigned short, (__bf16)f); }
__device__ __forceinline__ unsigned pk2(float lo, float hi) { typedef __bf16 bf2 __attribute__((ext_vector_type(2))); bf2 v; v[0] = (__bf16)lo; v[1] = (__bf16)hi; return __builtin_bit_cast(unsigned, v); }
__device__ __forceinline__ float lo16(unsigned u) { return __uint_as_float(u << 16); }
__device__ __forceinline__ float hi16(unsigned u) { return __uint_as_float(u & 0xffff0000u); }
template <int CTRL> __device__ __forceinline__ float dppf(float v) { return __int_as_float(__builtin_amdgcn_mov_dpp(__float_as_int(v), CTRL, 0xF, 0xF, true)); }
__device__ __forceinline__ float sum8(float v) { v += dppf<0xB1>(v); v += dppf<0x4E>(v); v += dppf<0x141>(v); return v; }
__device__ __forceinline__ float sum16(float v) { v = sum8(v); v += dppf<0x140>(v); return v; }
__device__ __forceinline__ float wave_sum(float v) {
    v = sum16(v);
    const int i = __float_as_int(v);
    return (__int_as_float(__builtin_amdgcn_readlane(i, 0)) + __int_as_float(__builtin_amdgcn_readlane(i, 16))) + (__int_as_float(__builtin_amdgcn_readlane(i, 32)) + __int_as_float(__builtin_amdgcn_readlane(i, 48)));
}
__device__ __forceinline__ float xor32(float v, int lane) { return __int_as_float(__builtin_amdgcn_ds_bpermute((lane ^ 32) << 2, __float_as_int(v))); }
__device__ __forceinline__ float sigmoidf_(float x) { return 1.0f / (1.0f + __expf(-x)); }
__device__ __forceinline__ float siluf_(float x) { return x / (1.0f + __expf(-x)); }
__device__ __forceinline__ float softplusf_(float z) { return fmaxf(z, 0.f) + log1pf(__expf(-fabsf(z))); }
__device__ __forceinline__ int crow(int reg, int hh) { return (reg & 3) + 8 * (reg >> 2) + 4 * hh; }
#define MFMA32(a, b, c) __builtin_amdgcn_mfma_f32_32x32x16_bf16((a), (b), (c), 0, 0, 0)

#define XB_TMO      128
#define XB_XCNT(j)  (256  + 64 * (j))
#define XB_XSUB(j)  (1280 + 64 * (j))
#define XB_XGEN(j)  (2304 + 64 * (j))
#define XB_TOP      3328
#define XB_TOPGEN   3392
#define XCD_BAR_WORDS 3456
#define XB_SPIN_CAP (1u << 18)

__device__ __forceinline__ unsigned xb_ld(unsigned* p)              { return __hip_atomic_load(p, __ATOMIC_RELAXED, __HIP_MEMORY_SCOPE_AGENT); }
__device__ __forceinline__ unsigned xb_add(unsigned* p, unsigned v) { return __hip_atomic_fetch_add(p, v, __ATOMIC_RELAXED, __HIP_MEMORY_SCOPE_AGENT); }
__device__ __forceinline__ unsigned xb_xcc_id() { return (unsigned)__builtin_amdgcn_s_getreg((3 << 11) | 20) & 0xFu; }
#define XB_SPIN(cond, bar) do { unsigned _sp = 0; while (cond) { __builtin_amdgcn_s_sleep(1); \
    if ((++_sp & 255u) == 0u) { if (xb_ld(&(bar)[XB_TMO])) break; if (_sp > XB_SPIN_CAP) { atomicAdd(&(bar)[XB_TMO], 1u); break; } } } } while (0)

struct XcdBarrier { unsigned* bar; unsigned x; volatile LAS unsigned* st; };

__device__ __forceinline__ XcdBarrier xcd_barrier_post(unsigned* bar, volatile LAS unsigned* st) {
    XcdBarrier b; b.bar = bar; b.x = xb_xcc_id(); b.st = st;
    if (threadIdx.x == 0) (void)xb_add(&bar[XB_XCNT(b.x)], 1u);
    return b;
}
__device__ __forceinline__ void xcd_barrier_complete(unsigned* bar, unsigned x, unsigned& nloc, unsigned& nx) {
    const unsigned G = gridDim.x * gridDim.y * gridDim.z;
    unsigned sum, cnt, mine, sp = 0u;
    for (;;) {
        sum = 0u; cnt = 0u; mine = 0u;
#pragma unroll 1
        for (unsigned j = 0; j < 16; ++j) { const unsigned c = xb_ld(&bar[XB_XCNT(j)]); sum += c; cnt += (c > 0u) ? 1u : 0u; mine = (j == x) ? c : mine; }
        if (sum == G) break;
        __builtin_amdgcn_s_sleep(1);
        if ((++sp & 255u) == 0u) { if (xb_ld(&bar[XB_TMO])) break; if (sp > XB_SPIN_CAP) { atomicAdd(&bar[XB_TMO], 1u); break; } }
    }
    nloc = mine > 0u ? mine : 1u; nx = cnt > 0u ? cnt : 1u;
}
__device__ __forceinline__ void xcd_barrier(const XcdBarrier& b) {
    asm volatile("s_waitcnt vmcnt(0)" ::: "memory");
    __syncthreads();
    if (threadIdx.x == 0) {
        unsigned* bar = b.bar;
        __builtin_amdgcn_s_waitcnt(0);
        unsigned nloc = b.st[0], nx = b.st[1];
        if (nloc == 0u) { xcd_barrier_complete(bar, b.x, nloc, nx); b.st[0] = nloc; b.st[1] = nx; }
        const unsigned old = xb_add(&bar[XB_XSUB(b.x)], 1u);
        const unsigned gen = old / nloc;
        if (old + 1u == (gen + 1u) * nloc) {
            __builtin_amdgcn_fence(__ATOMIC_RELEASE, "agent");
            asm volatile("s_waitcnt vmcnt(0)" ::: "memory");
            const unsigned og = xb_add(&bar[XB_TOP], 1u);
            const unsigned tg = og / nx;
            if (og + 1u == (tg + 1u) * nx) xb_add(&bar[XB_TOPGEN], 1u);
            else XB_SPIN(xb_ld(&bar[XB_TOPGEN]) == tg, bar);
            __builtin_amdgcn_fence(__ATOMIC_ACQUIRE, "agent");
            xb_add(&bar[XB_XGEN(b.x)], 1u);
            asm volatile("s_waitcnt vmcnt(0)" ::: "memory");
        } else {
            XB_SPIN(xb_ld(&bar[XB_XGEN(b.x)]) == gen, bar);
            __builtin_amdgcn_fence(__ATOMIC_ACQUIRE, "agent");
            asm volatile("s_waitcnt vmcnt(0)" ::: "memory");
        }
    }
    __syncthreads();
}

#ifndef A_AUX_WAIT
#define A_AUX_WAIT 16
#endif
namespace pg8 {
constexpr int BM = 256, BK = 64, HALF = 128, HTB = HALF * BK * 2, STAGE_BYTES = 8 * HTB, NXCD = 8, WGM = 8;
__host__ __device__ __forceinline__ int lds_byte(int r, int c) { const int st = (r >> 4) * 2 + (c >> 5), rr = r & 15, cc = c & 31, ob = rr * 64 + cc * 2; return st * 1024 + (ob ^ (((ob >> 9) & 1) << 5)); }
__host__ __device__ __forceinline__ void stage_rc(int b, int& R, int& C) { const int st = b / 1024, sb = b % 1024, swz = sb ^ (((sb >> 9) & 1) << 5); R = (st >> 1) * 16 + swz / 64; C = (st & 1) * 32 + (swz % 64) / 2; }
__host__ __device__ __forceinline__ int perm32(int rho) { const int n = rho >> 4, i = rho & 15; return 8 * (i >> 2) + 4 * n + (i & 3); }

struct Unit { const char* A; const char* B; const int* ridx; const float* wl; int nrows; int r0, c0, aux; };

template <class Epi, class Sched, bool GATHER>
__device__ __forceinline__ void gemm_phase(LAS unsigned char* lds, const int tid_in, const int K, const unsigned lda, const unsigned ldb, const Sched& S, const Epi& E) {
    const int tid = tid_in, wid = __builtin_amdgcn_readfirstlane(tid >> 6), lane = tid & 63, wr = wid >> 2, wc = wid & 3, fr = lane & 15, fq = lane >> 4;
    const int nt = K / BK;
    int sR[2], sC[2];
    unsigned voffA[2], voffB[2], cvA[2][2], nvA[2][2];
#pragma unroll
    for (int i = 0; i < 2; ++i) { int R, C; stage_rc(tid * 16 + i * 8192, R, C); sR[i] = R; sC[i] = C; const int Rb = Epi::PERM ? ((R & ~31) + perm32(R & 31)) : R;
        voffA[i] = (unsigned)R * lda + (unsigned)C * 2u; voffB[i] = (unsigned)Rb * ldb + (unsigned)C * 2u;
#pragma unroll
        for (int h = 0; h < 2; ++h) { cvA[h][i] = 0u; nvA[h][i] = 0u; } }
    const size_t kstep = (size_t)(BK * 2);
    const size_t hstepA = (size_t)HALF * lda, hstepB = (size_t)HALF * ldb;
    const unsigned ldsw = (unsigned)wid * 1024u;
    const int aoff = lds_byte(wr * 64 + fr, fq * 8), boff = lds_byte(wc * 32 + fr, fq * 8);
#define PG8_SA(b, h) (((b) * 2 + (h)) * HTB)
#define PG8_SB(b, h) ((4 + (b) * 2 + (h)) * HTB)
#define PG8_STGX(bufoff, gbase, o0, o1, AUX) do { \
        __builtin_amdgcn_global_load_lds((const unsigned*)((const char*)(gbase) + (o0)), (LAS unsigned*)(lds + (bufoff) + ldsw), 16, 0, AUX); \
        __builtin_amdgcn_global_load_lds((const unsigned*)((const char*)(gbase) + (o1)), (LAS unsigned*)(lds + (bufoff) + ldsw + 8192), 16, 0, AUX); } while (0)
#define PG8_STG(bufoff, gbase, o0, o1) PG8_STGX(bufoff, gbase, o0, o1, 0)
#define PG8_STGA(bufoff, gbase, h, NXT) do { if (GATHER) { const unsigned o0_ = (NXT) ? nvA[h][0] : cvA[h][0], o1_ = (NXT) ? nvA[h][1] : cvA[h][1]; PG8_STG(bufoff, gbase, o0_, o1_); } \
        else if (Sched::HAS_WAIT) { PG8_STGX(bufoff, (gbase) + (h) * hstepA, voffA[0], voffA[1], A_AUX_WAIT); } \
        else { PG8_STG(bufoff, (gbase) + (h) * hstepA, voffA[0], voffA[1]); } } while (0)
#define PG8_STGB(bufoff, gbase, h) PG8_STG(bufoff, (gbase) + (h) * hstepB, voffB[0], voffB[1])
#define PG8_LDA(dst, b, h) do { _Pragma("unroll") for (int m = 0; m < 4; ++m) _Pragma("unroll") for (int k = 0; k < 2; ++k) dst[m][k] = *(const LAS bf16x8*)(lds + PG8_SA(b, h) + aoff + m * 2048 + k * 1024); } while (0)
#define PG8_LDB(dst, b, h) do { _Pragma("unroll") for (int n = 0; n < 2; ++n) _Pragma("unroll") for (int k = 0; k < 2; ++k) dst[n][k] = *(const LAS bf16x8*)(lds + PG8_SB(b, h) + boff + n * 2048 + k * 1024); } while (0)
#define PG8_MMA(ai, bj, At, Bt) do { __builtin_amdgcn_s_setprio(1); _Pragma("unroll") for (int m = 0; m < 4; ++m) _Pragma("unroll") for (int n = 0; n < 2; ++n) _Pragma("unroll") for (int k = 0; k < 2; ++k) \
        acc[ai][bj][m][n] = __builtin_amdgcn_mfma_f32_16x16x32_bf16(Bt[n][k], At[m][k], acc[ai][bj][m][n], 0, 0, 0); __builtin_amdgcn_s_setprio(0); } while (0)
#define PG8_WAIT_V(n) asm volatile("s_waitcnt vmcnt(" #n ")" ::: "memory")
#define PG8_WAIT_L(n) asm volatile("s_waitcnt lgkmcnt(" #n ")" ::: "memory")
#define PG8_BAR __builtin_amdgcn_s_barrier()
#define PG8_SCHED __builtin_amdgcn_sched_barrier(0)
#define PG8_GOFF(u, dst) do { if (GATHER) { _Pragma("unroll") for (int i = 0; i < 2; ++i) _Pragma("unroll") for (int h = 0; h < 2; ++h) { const int x = sR[i] + 128 * h; \
        const int tok = (x < (u).nrows) ? ((u).ridx[x] >> 1) : 0; dst[h][i] = (unsigned)tok * lda + (unsigned)sC[i] * 2u; } } } while (0)
    Unit cur, nxt; int ui = 0;
    if (!S.next(0, cur)) return;
    if constexpr (Sched::HAS_WAIT) S.wait(cur);
    f32x4 acc[2][2][4][2];
#pragma unroll
    for (int a = 0; a < 2; ++a)
#pragma unroll
        for (int b = 0; b < 2; ++b)
#pragma unroll
            for (int m = 0; m < 4; ++m)
#pragma unroll
                for (int n = 0; n < 2; ++n) acc[a][b][m][n] = (f32x4){0.f, 0.f, 0.f, 0.f};
    bf16x8 At[4][2], B0[2][2], B1[2][2];
    const char* cA = cur.A; const char* cB = cur.B;
    PG8_GOFF(cur, cvA);
    PG8_STGB(PG8_SB(0, 0), cB, 0); PG8_STGA(PG8_SA(0, 0), cA, 0, false); PG8_STGB(PG8_SB(0, 1), cB, 1); PG8_STGA(PG8_SA(0, 1), cA, 1, false);
    if (wr == 1) PG8_BAR;
    PG8_WAIT_V(4); PG8_BAR;
    PG8_STGB(PG8_SB(1, 0), cB + kstep, 0); PG8_STGA(PG8_SA(1, 0), cA + kstep, 0, false); PG8_STGB(PG8_SB(1, 1), cB + kstep, 1);
    PG8_WAIT_V(6); PG8_BAR;
    for (;;) {
        const bool has_next = S.next(ui + 1, nxt);
        const char* nA = has_next ? nxt.A : cA; const char* nB = has_next ? nxt.B : cB;
        if (GATHER) { if (has_next) { PG8_GOFF(nxt, nvA); } else {
#pragma unroll
            for (int i = 0; i < 2; ++i)
#pragma unroll
                for (int h = 0; h < 2; ++h) nvA[h][i] = cvA[h][i]; } }
        for (int t = 0; t < nt; t += 2) {
            const bool last = (t == nt - 2);
            if constexpr (Sched::HAS_WAIT) { if (last && has_next) S.wait(nxt); }
            const char* a1 = cA + (size_t)(t + 1) * kstep;
            const char* a2 = last ? nA : cA + (size_t)(t + 2) * kstep; const char* b2 = last ? nB : cB + (size_t)(t + 2) * kstep;
            const char* a3 = a2 + kstep; const char* b3 = b2 + kstep;
            PG8_LDB(B0, 0, 0); PG8_SCHED; PG8_LDA(At, 0, 0); PG8_STGA(PG8_SA(1, 1), a1, 1, false);
            PG8_WAIT_L(8); PG8_BAR; PG8_WAIT_L(0); PG8_MMA(0, 0, At, B0); PG8_BAR; PG8_SCHED;
            PG8_LDB(B1, 0, 1); PG8_STGB(PG8_SB(0, 0), b2, 0);
            PG8_BAR; PG8_WAIT_L(0); PG8_MMA(0, 1, At, B1); PG8_BAR;
            PG8_LDA(At, 0, 1); PG8_STGA(PG8_SA(0, 0), a2, 0, last);
            PG8_BAR; PG8_WAIT_L(0); PG8_MMA(1, 0, At, B0); PG8_BAR; PG8_SCHED;
            PG8_STGB(PG8_SB(0, 1), b2, 1);
            PG8_WAIT_V(6); PG8_BAR; PG8_MMA(1, 1, At, B1); PG8_BAR;
            PG8_LDB(B0, 1, 0); PG8_SCHED; PG8_LDA(At, 1, 0); PG8_STGA(PG8_SA(0, 1), a2, 1, last);
            PG8_WAIT_L(8); PG8_BAR; PG8_WAIT_L(0); PG8_MMA(0, 0, At, B0); PG8_BAR; PG8_SCHED;
            PG8_LDB(B1, 1, 1); PG8_STGB(PG8_SB(1, 0), b3, 0);
            PG8_BAR; PG8_WAIT_L(0); PG8_MMA(0, 1, At, B1); PG8_BAR;
            PG8_LDA(At, 1, 1); PG8_STGA(PG8_SA(1, 0), a3, 0, last);
            PG8_BAR; PG8_WAIT_L(0); PG8_MMA(1, 0, At, B0); PG8_BAR; PG8_SCHED;
            PG8_STGB(PG8_SB(1, 1), b3, 1);
            PG8_WAIT_V(6); PG8_BAR; PG8_MMA(1, 1, At, B1); PG8_BAR;
        }
        E(acc, cur, wr, wc, fr, fq);
        if (!has_next) break;
#pragma unroll
        for (int a = 0; a < 2; ++a)
#pragma unroll
            for (int b = 0; b < 2; ++b)
#pragma unroll
                for (int m = 0; m < 4; ++m)
#pragma unroll
                    for (int n = 0; n < 2; ++n) acc[a][b][m][n] = (f32x4){0.f, 0.f, 0.f, 0.f};
        cur = nxt; cA = nA; cB = nB; ++ui;
        if (GATHER) {
#pragma unroll
            for (int i = 0; i < 2; ++i)
#pragma unroll
                for (int h = 0; h < 2; ++h) cvA[h][i] = nvA[h][i]; }
    }
    PG8_WAIT_V(0);
    if (wr == 0) PG8_BAR;
    PG8_BAR;
#undef PG8_SA
#undef PG8_SB
#undef PG8_STG
#undef PG8_STGX
#undef PG8_STGA
#undef PG8_STGB
#undef PG8_LDA
#undef PG8_LDB
#undef PG8_MMA
#undef PG8_WAIT_V
#undef PG8_WAIT_L
#undef PG8_BAR
#undef PG8_SCHED
#undef PG8_GOFF
}

struct DenseOrder {
    static constexpr bool HAS_WAIT = false;
    const char* A; const char* B; unsigned lda, ldb; int nM, nN, nwg, G, c;
    __device__ void init(const void* A_, const void* B_, unsigned lda_, unsigned ldb_, int M, int N, int G_, int c_) { A = (const char*)A_; B = (const char*)B_; lda = lda_; ldb = ldb_; nM = M / BM; nN = N / BM; nwg = nM * nN; G = G_; c = c_; }
    __device__ bool next(int i, Unit& u) const {
        const long L = (long)i * G + c; if (L >= nwg) return false;
        int wgid = (int)L; { const int q = nwg / NXCD, r = nwg % NXCD, xcd = wgid % NXCD, off = wgid / NXCD; wgid = (xcd < r ? xcd * (q + 1) : r * (q + 1) + (xcd - r) * q) + off; }
        const int nig = WGM * nN, gid = wgid / nig, fm = gid * WGM, gsz = (nM - fm) < WGM ? (nM - fm) : WGM;
        const int pm = fm + ((wgid % nig) % gsz), pn = (wgid % nig) / gsz;
        u.A = A + (size_t)pm * BM * lda; u.B = B + (size_t)pn * BM * ldb; u.ridx = nullptr; u.wl = nullptr; u.nrows = BM; u.r0 = pm * BM; u.c0 = pn * BM; u.aux = 0; return true;
    }
};
}
struct Args { const float* in[36]; float* out; unsigned char* ws; int ph_lo, ph_hi, flags, pad; };
struct Ctx {
    const float* const* in; float* out; unsigned char* ws; unsigned char* ws0;
    LAS unsigned char* lds; unsigned char* ldsg;
    int tid, lane, wave, G, bid, vcu, flags;
};
__device__ __forceinline__ void fresh(Ctx& C) {
    int t_ = threadIdx.x; asm volatile("" : "+v"(t_)); C.tid = t_; C.lane = t_ & 63; C.wave = __builtin_amdgcn_readfirstlane(t_ >> 6);
    int b_ = blockIdx.x; asm volatile("" : "+s"(b_)); C.bid = b_; int g_ = gridDim.x; asm volatile("" : "+s"(g_)); C.G = g_;
    C.vcu = (g_ % 8 == 0) ? (b_ % 8) * (g_ / 8) + b_ / 8 : b_;
    unsigned char* w_ = C.ws0; asm volatile("" : "+s"(w_)); C.ws = w_;
}
enum { IN_X = 0, IN_C, IN_ADAW, IN_ADAB, IN_N1G, IN_N2G, IN_WIN, IN_QNG, IN_KNG, IN_LAM, IN_SUBLN, IN_MU, IN_WUP, IN_W0, IN_AUP, IN_A0, IN_GUP, IN_KK, IN_KA, IN_RK, IN_LNG, IN_LNB,
       IN_GAUP, IN_GAB, IN_GNG, IN_PA, IN_PR, IN_PG, IN_WOUT, IN_RGW, IN_RGB, IN_REW, IN_REB, IN_EG, IN_EU, IN_ED };

__device__ __forceinline__ void transpose_item(const float* __restrict__ src, int ldn, int ns0, int nvalid, bf16_t* dst, int ldk, int nd0, int k0, LAS float* scr, int lane) {
    const int kq = lane >> 3, n4 = (lane & 7) * 4;
    f32x4 v[8];
#pragma unroll
    for (int i = 0; i < 8; ++i) { const int kk = 8 * i + kq; v[i] = (n4 < nvalid) ? *(const f32x4*)(src + (size_t)kk * ldn + ns0 + n4) : (f32x4){0.f, 0.f, 0.f, 0.f}; }
#pragma unroll
    for (int i = 0; i < 8; ++i) { const int kk = 8 * i + kq; LAS float* d = scr + kk * 33 + n4; d[0] = v[i][0]; d[1] = v[i][1]; d[2] = v[i][2]; d[3] = v[i][3]; }
    asm volatile("s_waitcnt lgkmcnt(0)" ::: "memory");
    const int c = lane & 7;
#pragma unroll
    for (int j = 0; j < 4; ++j) { const int n = (lane >> 3) + 8 * j; const LAS float* s = scr + (8 * c) * 33 + n;
        u32x4 o; o.x = pk2(s[0 * 33], s[1 * 33]); o.y = pk2(s[2 * 33], s[3 * 33]); o.z = pk2(s[4 * 33], s[5 * 33]); o.w = pk2(s[6 * 33], s[7 * 33]);
        *(u32x4*)(dst + (size_t)(nd0 + n) * ldk + k0 + 8 * c) = o; }
    asm volatile("s_waitcnt lgkmcnt(0)" ::: "memory");
}

__device__ __forceinline__ void phase_prologue(const Ctx& C) {
    float* cact = (float*)C.ldsg;
    float* red = (float*)(C.ldsg + 32768);
    if (C.bid < 192) {
        for (int i = C.tid; i < 8192; i += NTHR) { const float v = C.in[IN_C][i]; cact[i] = siluf_(v); }
        __syncthreads();
        for (int it = C.bid; it < 192; it += C.G) {
            const int l = it / 96, jb = it % 96, jj = C.tid & 63, ks = C.tid >> 6;
            const float* W = C.in[IN_ADAW] + (size_t)l * 1024 * 6144 + jb * 64 + jj;
            float a[8];
#pragma unroll
            for (int b = 0; b < 8; ++b) a[b] = 0.f;
            for (int k = ks * 128; k < ks * 128 + 128; ++k) { const float w = W[(size_t)k * 6144];
#pragma unroll
                for (int b = 0; b < 8; ++b) a[b] += cact[b * 1024 + k] * w; }
#pragma unroll
            for (int b = 0; b < 8; ++b) red[(ks * 8 + b) * 64 + jj] = a[b];
            __syncthreads();
            { const int b = C.tid >> 6; float s = 0.f;
#pragma unroll
              for (int k2 = 0; k2 < 8; ++k2) s += red[(k2 * 8 + b) * 64 + jj];
              ((float*)(C.ws + WS_MOD))[((size_t)l * 8 + b) * 6144 + jb * 64 + jj] = s + C.in[IN_ADAB][l * 6144 + jb * 64 + jj]; }
            __syncthreads();
        }
    }
    __syncthreads();
    LAS float* scr = (LAS float*)(C.lds + 65536 + C.wave * 8448);
    const int gw = C.bid * NWAVES + C.wave, NGW = C.G * NWAVES;
    constexpr int I_WIN = 2 * 16 * 256, I_PROJ = 6 * 8 * 32, I_WOUT = 2 * 16 * 32, I_LW = 2 * 4 * 16;
    for (int it = gw; it < I_WIN + I_PROJ + I_WOUT + I_LW; it += NGW) {
        int r = it;
        if (r >= I_WIN + I_PROJ + I_WOUT) { r -= I_WIN + I_PROJ + I_WOUT; const int l = r / 64, q = r % 64, kb4 = q / 16, nb = q % 16;
            const float* src = (kb4 == 0) ? C.in[IN_WUP] + (size_t)l * 64 * 512 : (kb4 == 1) ? C.in[IN_AUP] + (size_t)l * 64 * 512 : C.in[IN_GUP] + (size_t)l * 128 * 512 + (size_t)(kb4 - 2) * 64 * 512;
            transpose_item(src, 512, 32 * nb, 32, ((bf16_t*)(C.ws + WS_LW)) + (size_t)l * 512 * 256, 256, 32 * nb, 64 * kb4, scr, C.lane); continue; }
        if (r < I_WIN) { const int l = r / 4096, q = r % 4096, kb = q / 256, nb = q % 256, n0 = 32 * nb;
            int ns0 = 0, nv = 32;
            if (n0 < 4352) ns0 = n0; else if (n0 < 7936) ns0 = n0 + 16; else if (n0 == 7936) { ns0 = 4352; nv = 16; } else nv = 0;
            transpose_item(C.in[IN_WIN] + (size_t)l * 1024 * NIN_ + (size_t)(64 * kb) * NIN_, NIN_, ns0, nv, ((bf16_t*)(C.ws + WS_WIN)) + (size_t)l * NP_ * 1024, 1024, n0, 64 * kb, scr, C.lane); continue; }
        r -= I_WIN;
        if (r < I_PROJ) { const int lb = r / 256, q = r % 256, kb = q / 32, nb = q % 32, l = lb / 3, br = lb % 3;
            const float* src = C.in[IN_PA + br] + (size_t)l * 512 * 1024 + (size_t)(64 * kb) * 1024;
            transpose_item(src, 1024, 32 * nb, 32, ((bf16_t*)(C.ws + WS_WPROJ)) + (size_t)(l * 3 + br) * 1024 * 512, 512, 32 * nb, 64 * kb, scr, C.lane); continue; }
        r -= I_PROJ;
        { const int l = r / 512, q = r % 512, kb = q / 32, nb = q % 32;
          transpose_item(C.in[IN_WOUT] + (size_t)l * 1024 * 1024 + (size_t)(64 * kb) * 1024, 1024, 32 * nb, 32, ((bf16_t*)(C.ws + WS_WOUT)) + (size_t)l * 1024 * 1024, 1024, 32 * nb, 64 * kb, scr, C.lane); }
    }
}

__device__ __forceinline__ void phase_rows(const Ctx& C, int l, int mode) {
    const int gw = C.bid * NWAVES + C.wave, NGW = C.G * NWAVES;
    const float* xin = (mode & 1) ? C.out : C.in[IN_X];
    for (int t = gw; t < T_; t += NGW) {
        const int b = t >> 11;
        f32x4 v[4];
#pragma unroll
        for (int j = 0; j < 4; ++j) v[j] = *(const f32x4*)(xin + (size_t)t * 1024 + 4 * C.lane + 256 * j);
        if (mode & 1) {
            const float* gt2 = ((float*)(C.ws + WS_MOD)) + ((size_t)(l - 1) * 8 + b) * 6144 + 5120;
#pragma unroll
            for (int j = 0; j < 4; ++j) { const int col = 4 * C.lane + 256 * j;
                const u32x2 y0 = *(const u32x2*)(((bf16_t*)(C.ws + WS_YS)) + (size_t)(2 * t) * 1024 + col), y1 = *(const u32x2*)(((bf16_t*)(C.ws + WS_YS)) + (size_t)(2 * t + 1) * 1024 + col);
                const f32x4 g = *(const f32x4*)(gt2 + col);
                v[j][0] += g[0] * (lo16(y0.x) + lo16(y1.x)); v[j][1] += g[1] * (hi16(y0.x) + hi16(y1.x));
                v[j][2] += g[2] * (lo16(y0.y) + lo16(y1.y)); v[j][3] += g[3] * (hi16(y0.y) + hi16(y1.y));
                *(f32x4*)(C.out + (size_t)t * 1024 + col) = v[j]; }
        }
        if (mode & 2) {
            float ss = 0.f;
#pragma unroll
            for (int j = 0; j < 4; ++j) ss += v[j][0] * v[j][0] + v[j][1] * v[j][1] + v[j][2] * v[j][2] + v[j][3] * v[j][3];
            ss = wave_sum(ss);
            const float rstd = rsqrtf(ss * (1.f / 1024.f) + 1e-6f);
            const float* md = ((float*)(C.ws + WS_MOD)) + ((size_t)l * 8 + b) * 6144;
#pragma unroll
            for (int j = 0; j < 4; ++j) { const int col = 4 * C.lane + 256 * j;
                const f32x4 g = *(const f32x4*)(C.in[IN_N1G] + l * 1024 + col), sh = *(const f32x4*)(md + col), sc = *(const f32x4*)(md + 1024 + col);
                float o[4];
#pragma unroll
                for (int e = 0; e < 4; ++e) o[e] = v[j][e] * rstd * g[e] * (1.f + sc[e]) + sh[e];
                u32x2 w; w.x = pk2(o[0], o[1]); w.y = pk2(o[2], o[3]);
                *(u32x2*)(((bf16_t*)(C.ws + WS_H)) + (size_t)t * 1024 + col) = w; }
        }
    }
}

struct EpiP {
    static constexpr bool PERM = true; unsigned char* ws;
    __device__ __forceinline__ void operator()(const f32x4 (&acc)[2][2][4][2], const pg8::Unit& u, int wr, int wc, int fr, int fq) const {
        const int pn = u.c0 >> 8;
        size_t off; int mode = 0, ld = 0, hdsh = 6, nh = 8, cs0;
        if (pn < 2)        { off = WS_QH; mode = 1; hdsh = 6; nh = 8; cs0 = u.c0; }
        else if (pn < 4)   { off = WS_KH; mode = 1; hdsh = 6; nh = 8; cs0 = u.c0 - 512; }
        else if (pn < 6)   { off = WS_AV; ld = 512; cs0 = u.c0 - 1024; }
        else if (pn < 13)  { off = WS_RWS; ld = 1792; cs0 = u.c0 - 1536; }
        else if (pn < 14)  { off = WS_GQ; mode = 1; hdsh = 6; nh = 4; cs0 = 0; }
        else if (pn < 15)  { off = WS_GK; mode = 1; hdsh = 6; nh = 4; cs0 = 0; }
        else if (pn < 17)  { off = WS_GV; mode = 1; hdsh = 7; nh = 4; cs0 = u.c0 - 3840; }
        else if (pn < 19)  { off = WS_GG; mode = 1; hdsh = 7; nh = 4; cs0 = u.c0 - 4352; }
        else if (pn < 31)  { off = WS_GATES; ld = 3072; cs0 = u.c0 - 4864; }
        else               { off = WS_GAD; mode = 2; ld = 16; cs0 = 0; }
        bf16_t* base = (bf16_t*)(ws + off);
#pragma unroll
        for (int ai = 0; ai < 2; ++ai)
#pragma unroll
            for (int m = 0; m < 4; ++m) { const int row = u.r0 + 128 * ai + 64 * wr + 16 * m + fr; const int b = row >> 11, s = row & 2047;
#pragma unroll
                for (int bj = 0; bj < 2; ++bj) { const f32x4 v0 = acc[ai][bj][m][0], v1 = acc[ai][bj][m][1];
                    u32x4 w; w.x = pk2(v0[0], v0[1]); w.y = pk2(v0[2], v0[3]); w.z = pk2(v1[0], v1[1]); w.w = pk2(v1[2], v1[3]);
                    const int cs = cs0 + 128 * bj + 32 * wc + 8 * fq;
                    if (mode == 1) { const int hidx = cs >> hdsh, din = cs & ((1 << hdsh) - 1); *(u32x4*)(base + ((((size_t)b * nh + hidx) * S_ + s) << hdsh) + din) = w; }
                    else if (mode == 0) { *(u32x4*)(base + (size_t)row * ld + cs) = w; }
                    else { if (cs < 16) *(u32x4*)(base + (size_t)row * 16 + cs) = w; } } }
    }
};
struct EpiMerge {
    static constexpr bool PERM = true; const bf16_t* GATES; bf16_t* MG;
    __device__ __forceinline__ void operator()(const f32x4 (&acc)[2][2][4][2], const pg8::Unit& u, int wr, int wc, int fr, int fq) const {
#pragma unroll
        for (int ai = 0; ai < 2; ++ai)
#pragma unroll
            for (int m = 0; m < 4; ++m) { const size_t row = (size_t)(u.r0 + 128 * ai + 64 * wr + 16 * m + fr); const int col = u.c0 + 32 * wc + 8 * fq;
#pragma unroll
                for (int bj = 0; bj < 2; ++bj) { const f32x4 v0 = acc[ai][bj][m][0], v1 = acc[ai][bj][m][1];
                    const u32x4 g = *(const u32x4*)(GATES + row * 3072 + u.aux * 1024 + col + 128 * bj);
                    float o[8];
                    o[0] = sigmoidf_(lo16(g.x)) * v0[0]; o[1] = sigmoidf_(hi16(g.x)) * v0[1]; o[2] = sigmoidf_(lo16(g.y)) * v0[2]; o[3] = sigmoidf_(hi16(g.y)) * v0[3];
                    o[4] = sigmoidf_(lo16(g.z)) * v1[0]; o[5] = sigmoidf_(hi16(g.z)) * v1[1]; o[6] = sigmoidf_(lo16(g.w)) * v1[2]; o[7] = sigmoidf_(hi16(g.w)) * v1[3];
                    bf16_t* mp = MG + row * 1024 + col + 128 * bj;
                    if (u.aux > 0) { const u32x4 p = *(const u32x4*)mp;
                        o[0] += lo16(p.x); o[1] += hi16(p.x); o[2] += lo16(p.y); o[3] += hi16(p.y); o[4] += lo16(p.z); o[5] += hi16(p.z); o[6] += lo16(p.w); o[7] += hi16(p.w); }
                    u32x4 w; w.x = pk2(o[0], o[1]); w.y = pk2(o[2], o[3]); w.z = pk2(o[4], o[5]); w.w = pk2(o[6], o[7]);
                    *(u32x4*)mp = w; } }
    }
};
struct EpiOut {
    static constexpr bool PERM = false; const float* xin; float* out; const float* gt;
    __device__ __forceinline__ void operator()(const f32x4 (&acc)[2][2][4][2], const pg8::Unit& u, int wr, int wc, int fr, int fq) const {
#pragma unroll
        for (int ai = 0; ai < 2; ++ai)
#pragma unroll
            for (int m = 0; m < 4; ++m) { const int row = u.r0 + 128 * ai + 64 * wr + 16 * m + fr; const int b = row >> 11;
#pragma unroll
                for (int bj = 0; bj < 2; ++bj)
#pragma unroll
                    for (int n = 0; n < 2; ++n) { const int col = u.c0 + 128 * bj + 32 * wc + 16 * n + 4 * fq;
                        const f32x4 x = *(const f32x4*)(xin + (size_t)row * 1024 + col), g = *(const f32x4*)(gt + (size_t)b * 6144 + col);
                        *(f32x4*)(out + (size_t)row * 1024 + col) = x + g * acc[ai][bj][m][n]; } }
    }
};
#ifndef HID_WT
#define HID_WT 1
#endif
struct EpiHid {
    static constexpr bool PERM = true; bf16_t* HID; unsigned* done;
    __device__ __forceinline__ void operator()(const f32x4 (&acc)[2][2][4][2], const pg8::Unit& u, int wr, int wc, int fr, int fq) const {
#pragma unroll
        for (int ai = 0; ai < 2; ++ai)
#pragma unroll
            for (int m = 0; m < 4; ++m) { bf16_t* rowp = HID + (size_t)(u.r0 + 128 * ai + 64 * wr + 16 * m + fr) * 512 + u.c0 + 32 * wc + 8 * fq;
                float o[8];
#pragma unroll
                for (int n = 0; n < 2; ++n)
#pragma unroll
                    for (int j = 0; j < 4; ++j) o[4 * n + j] = siluf_(acc[ai][0][m][n][j]) * acc[ai][1][m][n][j];
                u32x4 w; w.x = pk2(o[0], o[1]); w.y = pk2(o[2], o[3]); w.z = pk2(o[4], o[5]); w.w = pk2(o[6], o[7]);
#if HID_WT
                asm volatile("global_store_dwordx4 %0, %1, off sc1\n\ts_nop 2" :: "v"(rowp), "v"(w) : "memory"); }
#else
                *(u32x4*)rowp = w; }
        __builtin_amdgcn_fence(__ATOMIC_RELEASE, "agent");
#endif
        asm volatile("s_waitcnt vmcnt(0)" ::: "memory");
        if (fr == 0 && fq == 0) __hip_atomic_store(done + 32 * (u.r0 >> 8) + 8 * (u.c0 >> 7) + 4 * wr + wc, 1u, __ATOMIC_RELAXED, __HIP_MEMORY_SCOPE_AGENT);
    }
};
struct EpiDown {
    static constexpr bool PERM = true; bf16_t* YS;
    __device__ __forceinline__ void operator()(const f32x4 (&acc)[2][2][4][2], const pg8::Unit& u, int wr, int wc, int fr, int fq) const {
#pragma unroll
        for (int ai = 0; ai < 2; ++ai)
#pragma unroll
            for (int m = 0; m < 4; ++m) { const int rloc = 128 * ai + 64 * wr + 16 * m + fr;
                if (rloc < u.nrows) { const int slot = u.ridx[rloc]; const float wgt = u.wl[rloc];
                    bf16_t* rowp = YS + (size_t)slot * 1024 + u.c0 + 32 * wc + 8 * fq;
#pragma unroll
                    for (int bj = 0; bj < 2; ++bj) { const f32x4 v0 = acc[ai][bj][m][0] * wgt, v1 = acc[ai][bj][m][1] * wgt;
                        u32x4 w; w.x = pk2(v0[0], v0[1]); w.y = pk2(v0[2], v0[3]); w.z = pk2(v1[0], v1[1]); w.w = pk2(v1[2], v1[3]);
                        *(u32x4*)(rowp + 128 * bj) = w; } } }
    }
};
struct WinOrder {
    static constexpr bool HAS_WAIT = false;
    const char* A; const char* B; int G, c;
    __device__ bool next(int i, pg8::Unit& u) const {
        constexpr int nM = 64, nN = 24, nwg = nM * nN;
        const long L = (long)i * G + c; if (L >= nwg) return false;
        int wgid = (int)L; { const int q = nwg / 8, r = nwg % 8, xcd = wgid % 8, off = wgid / 8; wgid = (xcd < r ? xcd * (q + 1) : r * (q + 1) + (xcd - r) * q) + off; }
        const int nig = 8 * nN, gid = wgid / nig, fm = gid * 8;
        const int pm = fm + ((wgid % nig) % 8); int pn = (wgid % nig) / 8; pn = (pn < 23) ? pn : 31;
        u.A = A + (size_t)pm * 256 * 2048; u.B = B + (size_t)pn * 256 * 2048; u.ridx = nullptr; u.wl = nullptr; u.nrows = 256; u.r0 = pm * 256; u.c0 = pn * 256; u.aux = 0; return true;
    }
};
struct GateOrder {
    static constexpr bool HAS_WAIT = false;
    const char* A; const char* B; int q;
    __device__ bool next(int i, pg8::Unit& u) const {
        if (i >= 4) return false;
        const int pm = q >> 1, pn = 23 + 4 * (q & 1) + i;
        u.A = A + (size_t)pm * 256 * 2048; u.B = B + (size_t)pn * 256 * 2048; u.ridx = nullptr; u.wl = nullptr; u.nrows = 256; u.r0 = pm * 256; u.c0 = pn * 256; u.aux = 0; return true;
    }
};
struct MergeOrder {
    static constexpr bool HAS_WAIT = false;
    const bf16_t *O0, *O1, *O2; const bf16_t* W; int G, c;
    __device__ bool next(int i, pg8::Unit& u) const {
        const int br = i % 3, tile = c + (i / 3) * G; if (tile >= 256) return false;
        const int pm = tile >> 2, pn = tile & 3;
        const bf16_t* Ob = (br == 0) ? O0 : ((br == 1) ? O1 : O2); u.A = (const char*)(Ob + (size_t)pm * 256 * 512); u.B = (const char*)(W + (size_t)br * 1024 * 512 + (size_t)pn * 256 * 512);
        u.ridx = nullptr; u.wl = nullptr; u.nrows = 256; u.r0 = pm * 256; u.c0 = pn * 256; u.aux = br; return true;
    }
};
struct MoeOrder {
    static constexpr bool HAS_WAIT = true;
    const LAS int* tab; const char* A; const char* B; const int* LIST; const float* WL; int G, c, down; const unsigned* done;
    __device__ __forceinline__ void wait(const pg8::Unit& u) const {
        if (down) { const int ln = (int)__builtin_amdgcn_mbcnt_hi(~0u, __builtin_amdgcn_mbcnt_lo(~0u, 0u)) & 31;
            const unsigned* p = done + 32 * (u.r0 >> 8) + ln; int spins = 0;
            while (!__all(__hip_atomic_load(p, __ATOMIC_RELAXED, __HIP_MEMORY_SCOPE_AGENT) == 1u) && ++spins < (1 << 22)) __builtin_amdgcn_s_sleep(2);
            if (A_AUX_WAIT == 0) __builtin_amdgcn_fence(__ATOMIC_ACQUIRE, "agent");
            else asm volatile("s_waitcnt vmcnt(0)" ::: "memory"); }
    }
    __device__ bool next(int i, pg8::Unit& u) const {
        const int nU = 4 * tab[32];
        int L = i * G + c;
        if (down) { int r = nU - 2 * G; r = r < 0 ? 0 : (r > G ? G : r); const int nW = G - r;
            if (c >= r) L = (i < 3) ? i * nW + (c - r) : 3 * nW + (i - 3) * G + c; else L = 3 * nW + i * G + c; }
        const int R = L >> 2, ct = L & 3; if (L >= nU) return false;
        int e = 0;
#pragma unroll 1
        while (tab[e + 1] <= R) ++e;
        const int rt = R - tab[e], n = tab[33 + e] - 256 * rt;
        u.nrows = n < 256 ? n : 256; u.ridx = LIST + (size_t)e * ECAP + 256 * rt; u.wl = WL + (size_t)e * ECAP + 256 * rt; u.aux = e;
        if (!down) { u.A = A; u.B = B + ((size_t)e * 1024 + 256 * ct) * 2048; u.r0 = 256 * R; u.c0 = 128 * ct; }
        else       { u.A = A + (size_t)256 * R * 1024; u.B = B + ((size_t)e * 1024 + 256 * ct) * 1024; u.r0 = 256 * R; u.c0 = 256 * ct; }
        return true;
    }
};
__device__ __forceinline__ void moe_build_table(const Ctx& C, int l) {
    LAS int* tab = (LAS int*)(C.lds + LDS_SCHED);
    if (C.tid == 0) { int acc = 0;
        for (int e = 0; e < 32; ++e) { const int n = (int)__hip_atomic_load(((unsigned*)(C.ws + WS_CTL)) + CW_CNT + l * 2048 + 64 * e, __ATOMIC_RELAXED, __HIP_MEMORY_SCOPE_AGENT); tab[e] = acc; tab[33 + e] = n; acc += (n + 255) >> 8; }
        tab[32] = acc; }
    __syncthreads();
}
__device__ __forceinline__ float mixv(float x, float prev, float mu) { return x + (prev - x) * mu; }
__device__ __forceinline__ void phase_prep(const Ctx& C, int l) {
    bf16_t* xs = (bf16_t*)C.ldsg;
    bf16_t* vts = (bf16_t*)(C.ldsg + 32768);
    float* gs = (float*)(C.ldsg + 16896);
    constexpr int PS_STG = 20480, PS_ARR = 32 * 144, PS_SLOT = 6 * PS_ARR, PS_RED = 131072;
    const int tid = C.tid, lane = C.lane;
    const float* mu = C.in[IN_MU] + l * 1792;
    for (int item = C.bid; item < T_ / 32; item += C.G) {
        const int t0 = item * 32, b = t0 >> 11, s0 = t0 & 2047;
        const bf16_t* RWt = ((const bf16_t*)(C.ws + WS_RWS)) + (size_t)t0 * 1792;
        if (!(C.flags & 16)) { const int g = tid >> 5, tok = tid & 31;
          bf16_t* p = ((bf16_t*)(C.ws + (g < 8 ? WS_QH : WS_KH))) + (((size_t)b * 8 + (g & 7)) * S_ + s0 + tok) * 64; u32x4 raw[8]; float ss = 0.f;
#pragma unroll
          for (int i = 0; i < 8; ++i) { raw[i] = *(const u32x4*)(p + 8 * i);
#pragma unroll
              for (int e = 0; e < 4; ++e) { const float a = lo16(raw[i][e]), c2 = hi16(raw[i][e]); ss += a * a + c2 * c2; } }
          const float rstd = rsqrtf(ss * (1.f / 64.f) + 1e-6f) * ((g < 8) ? 0.125f : 1.0f);
          const float* gn = (g < 8) ? C.in[IN_QNG] + l * 64 : C.in[IN_KNG] + l * 64;
#pragma unroll
          for (int i = 0; i < 8; ++i) { u32x4 w;
#pragma unroll
              for (int e = 0; e < 4; ++e) w[e] = pk2(lo16(raw[i][e]) * rstd * gn[8 * i + 2 * e], hi16(raw[i][e]) * rstd * gn[8 * i + 2 * e + 1]);
              *(u32x4*)(p + 8 * i) = w; } }
#pragma unroll
        for (int i = 0; i < 4; ++i) { const int idx = tid + 512 * i, tok = idx >> 6, c8 = idx & 63;
            *(u32x4*)(vts + tok * 512 + c8 * 8) = *(const u32x4*)(((const bf16_t*)(C.ws + WS_AV)) + (size_t)(t0 + tok) * 512 + c8 * 8); }
        { const int tok = tid >> 4, i = tid & 15; gs[tok * 16 + i] = bf2f(((const bf16_t*)(C.ws + WS_GAD))[(size_t)(t0 + tok) * 16 + i]); }
        if (tid < 256) { const int j = tid, col = 1536 + j; const float m_ = mu[1536 + j];
            float prev = (s0 == 0) ? 0.f : bf2f(RWt[col - 1792]);
#pragma unroll
            for (int t = 0; t < 32; ++t) { const float x = bf2f(RWt[(size_t)t * 1792 + col]); const float mv = mixv(x, prev, m_); prev = x;
                float val; if (j < 64) { const float e2 = __expf(2.f * mv); val = 1.f - 2.f / (e2 + 1.f); } else if (j < 128) val = mv; else val = sigmoidf_(mv);
                xs[t * 264 + j] = f2bf(val); } }
        __syncthreads();
        if (!(C.flags & 32)) { u32x4 o[4];
#pragma unroll
          for (int q = 0; q < 4; ++q)
#pragma unroll
              for (int e = 0; e < 4; ++e) { const unsigned a = vts[(8 * q + 2 * e) * 512 + tid], c2 = vts[(8 * q + 2 * e + 1) * 512 + tid]; o[q][e] = a | (c2 << 16); }
          bf16_t* dst = ((bf16_t*)(C.ws + WS_VT)) + ((((size_t)b * 4 + (tid >> 7)) * 64 + (s0 >> 5)) * 128 + (tid & 127)) * 32;
#pragma unroll
          for (int q = 0; q < 4; ++q) *(u32x4*)(dst + 8 * q) = o[q]; }
        if (!(C.flags & 128)) { const int j = tid & 255, half = tid >> 8; float au[16];
#pragma unroll
          for (int i = 0; i < 16; ++i) au[i] = C.in[IN_GAUP][(size_t)l * 16 * 256 + i * 256 + j];
          const float ab = C.in[IN_GAB][l * 256 + j];
          float* la = ((float*)(C.ws + WS_LA)) + (((size_t)b * 4 + (j >> 6)) * S_ + s0) * 64 + (j & 63);
          for (int t = half * 16; t < half * 16 + 16; ++t) { float z = ab;
#pragma unroll
              for (int i = 0; i < 16; ++i) z += gs[t * 16 + i] * au[i];
              la[(size_t)t * 64] = -softplusf_(-z) * (1.f / 16.f); } }
        __syncthreads();
        if (!(C.flags & 64)) {
        const int r = lane & 31, hh = lane >> 5, w = C.wave, slot = w & 3, tile = w >> 2;
        const bf16_t* LW = ((const bf16_t*)(C.ws + WS_LW)) + (size_t)l * 512 * 256;
        const bool has_prev = !(s0 == 0 && r == 0);
        const bf16_t* xrow = RWt + (size_t)r * 1792; const bf16_t* xprev = xrow - 1792;
        float* red = (float*)(C.ldsg + PS_RED);
#pragma unroll 1
        for (int pass = 0; pass < 2; ++pass) {
            const int hd = 4 * pass + slot, ch0 = 64 * hd + 32 * tile;
            unsigned char* stg = C.ldsg + PS_STG + slot * PS_SLOT + r * 144 + (32 * tile + 4 * hh) * 2;
            float ssq = 0.f, bon = 0.f;
            f32x16 aw, aa, ag;
#pragma unroll
            for (int i = 0; i < 16; ++i) { aw[i] = 0.f; aa[i] = 0.f; ag[i] = 0.f; }
            const bf16_t* wrow = LW + (size_t)(ch0 + r) * 256 + 8 * hh;
#pragma unroll
            for (int s = 0; s < 4; ++s) aw = MFMA32(*(const bf16x8*)(wrow + 16 * s), *(const bf16x8*)(xs + r * 264 + 16 * s + 8 * hh), aw);
#pragma unroll
            for (int s = 0; s < 4; ++s) aa = MFMA32(*(const bf16x8*)(wrow + 64 + 16 * s), *(const bf16x8*)(xs + r * 264 + 64 + 16 * s + 8 * hh), aa);
#pragma unroll
            for (int s = 0; s < 8; ++s) ag = MFMA32(*(const bf16x8*)(wrow + 128 + 16 * s), *(const bf16x8*)(xs + r * 264 + 128 + 16 * s + 8 * hh), ag);
#pragma unroll
            for (int g = 0; g < 4; ++g) { const int ch = ch0 + 8 * g + 4 * hh;
                const size_t o = (size_t)(t0 + r) * 512 + ch;
                const f32x4 w0 = *(const f32x4*)(C.in[IN_W0] + l * 512 + ch), a0 = *(const f32x4*)(C.in[IN_A0] + l * 512 + ch);
                const f32x4 mur = *(const f32x4*)(mu + ch), muk = *(const f32x4*)(mu + 512 + ch), muv = *(const f32x4*)(mu + 1024 + ch);
                const f32x4 kkc = *(const f32x4*)(C.in[IN_KK] + l * 512 + ch), kac = *(const f32x4*)(C.in[IN_KA] + l * 512 + ch), rkc = *(const f32x4*)(C.in[IN_RK] + l * 512 + ch);
                const u32x2 ur = *(const u32x2*)(xrow + ch), uk = *(const u32x2*)(xrow + 512 + ch), uv = *(const u32x2*)(xrow + 1024 + ch);
                u32x2 pr = {0u, 0u}, pk = {0u, 0u}, pv = {0u, 0u};
                if (has_prev) { pr = *(const u32x2*)(xprev + ch); pk = *(const u32x2*)(xprev + 512 + ch); pv = *(const u32x2*)(xprev + 1024 + ch); }
                const float xr_[4] = {lo16(ur.x), hi16(ur.x), lo16(ur.y), hi16(ur.y)}, xk_[4] = {lo16(uk.x), hi16(uk.x), lo16(uk.y), hi16(uk.y)}, xv_[4] = {lo16(uv.x), hi16(uv.x), lo16(uv.y), hi16(uv.y)};
                const float qr_[4] = {lo16(pr.x), hi16(pr.x), lo16(pr.y), hi16(pr.y)}, qk_[4] = {lo16(pk.x), hi16(pk.x), lo16(pk.y), hi16(pk.y)}, qv_[4] = {lo16(pv.x), hi16(pv.x), lo16(pv.y), hi16(pv.y)};
                float ld4[4], g4[4], r4[4], kp4[4], v4[4], kr4[4], bb4[4];
#pragma unroll
                for (int e = 0; e < 4; ++e) { const int i = 4 * g + e;
                    const float wv = -softplusf_(-(w0[e] + aw[i])) - 0.5f; ld4[e] = -__expf(wv);
                    const float a = sigmoidf_(a0[e] + aa[i]); g4[e] = ag[i];
                    const float rr = mixv(xr_[e], qr_[e], mur[e]), kk = mixv(xk_[e], qk_[e], muk[e]), vv = mixv(xv_[e], qv_[e], muv[e]);
                    const float kk_ = kk * kkc[e]; kr4[e] = kk_; bb4[e] = kk_ * a; ssq += kk_ * kk_;
                    const float kp = kk * (1.f + (a - 1.f) * kac[e]); bon += rr * kp * rkc[e];
                    r4[e] = rr; kp4[e] = kp; v4[e] = vv; }
                *(f32x4*)(((float*)(C.ws + WS_RLD)) + o) = (f32x4){ld4[0], ld4[1], ld4[2], ld4[3]};
                u32x2 t2; unsigned char* sp = stg + 16 * g;
                t2.x = pk2(g4[0], g4[1]); t2.y = pk2(g4[2], g4[3]); *(u32x2*)(sp) = t2;
                t2.x = pk2(r4[0], r4[1]); t2.y = pk2(r4[2], r4[3]); *(u32x2*)(sp + PS_ARR) = t2;
                t2.x = pk2(kp4[0], kp4[1]); t2.y = pk2(kp4[2], kp4[3]); *(u32x2*)(sp + 2 * PS_ARR) = t2;
                t2.x = pk2(v4[0], v4[1]); t2.y = pk2(v4[2], v4[3]); *(u32x2*)(sp + 3 * PS_ARR) = t2;
                t2.x = pk2(kr4[0], kr4[1]); t2.y = pk2(kr4[2], kr4[3]); *(u32x2*)(sp + 4 * PS_ARR) = t2;
                t2.x = pk2(bb4[0], bb4[1]); t2.y = pk2(bb4[2], bb4[3]); *(u32x2*)(sp + 5 * PS_ARR) = t2;
                __builtin_amdgcn_sched_barrier(0); }
            ssq += xor32(ssq, lane); bon += xor32(bon, lane);
            if (hh == 0) { red[((slot * 2 + tile) * 32 + r) * 2] = ssq; red[((slot * 2 + tile) * 32 + r) * 2 + 1] = bon; }
            __syncthreads();
#pragma unroll 4
            for (int i = 0; i < 12; ++i) { const int P = tid + 512 * i, sl = P / 1536, rem = P - sl * 1536, arr = rem >> 8, row = (rem & 255) >> 3, piece = rem & 7;
                const u32x4 v = *(const u32x4*)(C.ldsg + PS_STG + sl * PS_SLOT + arr * PS_ARR + row * 144 + piece * 16);
                const size_t aoff = (arr == 0) ? WS_RG : (arr == 1) ? WS_RR : (arr == 2) ? WS_RK : (arr == 3) ? WS_RV : (arr == 4) ? WS_RKK : WS_RBB;
                *(u32x4*)(((bf16_t*)(C.ws + aoff)) + (size_t)(t0 + row) * 512 + (4 * pass + sl) * 64 + piece * 8) = v; }
            if (tid < 128) { const int sl = tid >> 5, tk = tid & 31;
                const float sq = red[((sl * 2) * 32 + tk) * 2] + red[((sl * 2 + 1) * 32 + tk) * 2], bn = red[((sl * 2) * 32 + tk) * 2 + 1] + red[((sl * 2 + 1) * 32 + tk) * 2 + 1];
                const float nrm = fmaxf(sqrtf(sq), 1e-12f);
                ((float*)(C.ws + WS_RC))[(size_t)(t0 + tk) * 8 + 4 * pass + sl] = 1.f / (nrm * nrm);
                ((float*)(C.ws + WS_RBON))[(size_t)(t0 + tk) * 8 + 4 * pass + sl] = bn; }
            __syncthreads();
        }
        }
        __syncthreads();
    }
}

constexpr int RW_WGS = 128;
__device__ __forceinline__ void rwkv_wg(const Ctx& C0, int l, int item) {
    Ctx C = C0; fresh(C);
    const int bh = item >> 1, rh = item & 1, b = bh >> 3, h = bh & 7, tid = C.tid, lane = C.lane;
    float* dec = (float*)C.ldsg; float* skk = dec + 2048; float* sbb = dec + 4096; float* skp = dec + 6144; float* srr = dec + 8192;
    bf16_t* svv = (bf16_t*)(C.ldsg + 40960);
    float* yb = (float*)(C.ldsg + 45056);
    const int rloc = 4 * C.wave + (lane >> 4), row = 32 * rh + rloc, kq = lane & 15;
    float s0 = 0.f, s1 = 0.f, s2 = 0.f, s3 = 0.f;
    const int lstep = tid >> 4, lc4 = tid & 15;
    const size_t o0 = ((size_t)b * S_ + lstep) * 512 + h * 64 + 4 * lc4; const int lo = lstep * 64 + 4 * lc4;
    f32x4 nld = *(const f32x4*)(((const float*)(C.ws + WS_RLD)) + o0);
    u32x2 nkk = *(const u32x2*)(((const bf16_t*)(C.ws + WS_RKK)) + o0), nbb = *(const u32x2*)(((const bf16_t*)(C.ws + WS_RBB)) + o0), nkp = *(const u32x2*)(((const bf16_t*)(C.ws + WS_RK)) + o0),
          nrr = *(const u32x2*)(((const bf16_t*)(C.ws + WS_RR)) + o0), nvv = *(const u32x2*)(((const bf16_t*)(C.ws + WS_RV)) + o0);
    float ncs = ((const float*)(C.ws + WS_RC))[((size_t)b * S_ + lstep) * 8 + h];
    for (int blk = 0; blk < S_ / 32; ++blk) {
        const size_t tb = (size_t)b * S_ + blk * 32;
        { f32x4 d; d[0] = __expf(nld[0]); d[1] = __expf(nld[1]); d[2] = __expf(nld[2]); d[3] = __expf(nld[3]);
          *(f32x4*)(dec + lo) = d;
          *(f32x4*)(skk + lo) = (f32x4){lo16(nkk.x), hi16(nkk.x), lo16(nkk.y), hi16(nkk.y)};
          *(f32x4*)(sbb + lo) = (f32x4){lo16(nbb.x) * ncs, hi16(nbb.x) * ncs, lo16(nbb.y) * ncs, hi16(nbb.y) * ncs};
          *(f32x4*)(skp + lo) = (f32x4){lo16(nkp.x), hi16(nkp.x), lo16(nkp.y), hi16(nkp.y)};
          *(f32x4*)(srr + lo) = (f32x4){lo16(nrr.x), hi16(nrr.x), lo16(nrr.y), hi16(nrr.y)};
          *(u32x2*)(svv + lo) = nvv; }
        __syncthreads();
        if (blk + 1 < S_ / 32) { const size_t o = o0 + (size_t)(blk + 1) * 32 * 512;
            nld = *(const f32x4*)(((const float*)(C.ws + WS_RLD)) + o);
            nkk = *(const u32x2*)(((const bf16_t*)(C.ws + WS_RKK)) + o); nbb = *(const u32x2*)(((const bf16_t*)(C.ws + WS_RBB)) + o); nkp = *(const u32x2*)(((const bf16_t*)(C.ws + WS_RK)) + o);
            nrr = *(const u32x2*)(((const bf16_t*)(C.ws + WS_RR)) + o); nvv = *(const u32x2*)(((const bf16_t*)(C.ws + WS_RV)) + o);
            ncs = ((const float*)(C.ws + WS_RC))[(tb + 32 + lstep) * 8 + h]; }
#pragma unroll
        for (int tg = 0; tg < 2; ++tg) {
            float ykeep = 0.f;
#pragma unroll
            for (int tt = 0; tt < 16; ++tt) { const int t = 16 * tg + tt;
                const f32x4 dc = *(const f32x4*)(dec + t * 64 + 4 * kq), kk = *(const f32x4*)(skk + t * 64 + 4 * kq), bb = *(const f32x4*)(sbb + t * 64 + 4 * kq),
                            kp = *(const f32x4*)(skp + t * 64 + 4 * kq), rr = *(const f32x4*)(srr + t * 64 + 4 * kq);
                const float vr = bf2f(svv[t * 64 + row]);
                float sa = (s0 * kk[0] + s1 * kk[1]) + (s2 * kk[2] + s3 * kk[3]);
                const float t0_ = s0 * dc[0] + vr * kp[0], t1_ = s1 * dc[1] + vr * kp[1], t2_ = s2 * dc[2] + vr * kp[2], t3_ = s3 * dc[3] + vr * kp[3];
                sa = sum16(sa);
                s0 = t0_ - sa * bb[0]; s1 = t1_ - sa * bb[1]; s2 = t2_ - sa * bb[2]; s3 = t3_ - sa * bb[3];
                float y = (s0 * rr[0] + s1 * rr[1]) + (s2 * rr[2] + s3 * rr[3]);
                y = sum16(y);
                ykeep = (kq == tt) ? y : ykeep;
            }
            yb[(16 * tg + kq) * 32 + rloc] = ykeep;
        }
        __syncthreads();
        { const int st = tid >> 4, c2 = (tid & 15) * 2;
          float* yo = ((float*)(C.ws + WS_RY)) + (tb + st) * 512 + h * 64 + 32 * rh + c2;
          *(float2*)yo = *(const float2*)(yb + st * 32 + c2); }
    }
}
__device__ __forceinline__ void rwkv_finish(const Ctx& C, int l) {
    const int gw = C.bid * NWAVES + C.wave, NGW = C.G * NWAVES, lane = C.lane;
    const float* lng = C.in[IN_LNG] + l * 512; const float* lnb = C.in[IN_LNB] + l * 512;
    for (int t = gw; t < T_; t += NGW) {
        const float* yp = ((const float*)(C.ws + WS_RY)) + (size_t)t * 512 + 8 * lane;
        const f32x4 y0 = *(const f32x4*)yp, y1 = *(const f32x4*)(yp + 4);
        float sm = (y0[0] + y0[1] + y0[2] + y0[3]) + (y1[0] + y1[1] + y1[2] + y1[3]);
        sm = sum8(sm); const float mean = sm * (1.f / 64.f);
        float e[8];
#pragma unroll
        for (int i = 0; i < 4; ++i) { e[i] = y0[i] - mean; e[4 + i] = y1[i] - mean; }
        float vs = 0.f;
#pragma unroll
        for (int i = 0; i < 8; ++i) vs += e[i] * e[i];
        vs = sum8(vs); const float rstd = rsqrtf(vs * (1.f / 64.f) + 64e-5f);
        const float bon = ((const float*)(C.ws + WS_RBON))[(size_t)t * 8 + (lane >> 3)];
        const u32x4 uv = *(const u32x4*)(((const bf16_t*)(C.ws + WS_RV)) + (size_t)t * 512 + 8 * lane), ug = *(const u32x4*)(((const bf16_t*)(C.ws + WS_RG)) + (size_t)t * 512 + 8 * lane);
        float o[8];
#pragma unroll
        for (int i = 0; i < 4; ++i) { const int c = 8 * lane + 2 * i;
            o[2 * i] = (e[2 * i] * rstd * lng[c] + lnb[c] + bon * lo16(uv[i])) * lo16(ug[i]);
            o[2 * i + 1] = (e[2 * i + 1] * rstd * lng[c + 1] + lnb[c + 1] + bon * hi16(uv[i])) * hi16(ug[i]); }
        u32x4 w; w.x = pk2(o[0], o[1]); w.y = pk2(o[2], o[3]); w.z = pk2(o[4], o[5]); w.w = pk2(o[6], o[7]);
        *(u32x4*)(((bf16_t*)(C.ws + WS_OR)) + (size_t)t * 512 + 8 * lane) = w;
    }
}

constexpr int GL_BC = 0, GL_QT = 16896, GL_KT = 26112, GL_KHT = 35328, GL_VT = 44544, GL_ST = 62976, GL_PM = 81408, GL_OB = 90624, GL_GT = 124416, GL_LD = 72, GL_BS = 65;
__device__ __forceinline__ bf16x8 ldfrag(const LAS unsigned char* lds, int off, int row0, int k0, int lane) {
    return *(const LAS bf16x8*)(lds + off + ((row0 + (lane & 31)) * GL_LD + k0 + 8 * (lane >> 5)) * 2);
}
__device__ __forceinline__ void gla_wg(const Ctx& C0, int l, int bh) {
    Ctx C = C0; fresh(C);
    const int h = bh & 3, tid = C.tid, lane = C.lane, w = C.wave, r = lane & 31, hh = lane >> 5;
    float* Bc = (float*)(C.ldsg + GL_BC);
    bf16_t* Qt = (bf16_t*)(C.ldsg + GL_QT); bf16_t* Kt = (bf16_t*)(C.ldsg + GL_KT); bf16_t* KhT = (bf16_t*)(C.ldsg + GL_KHT);
    bf16_t* VTs = (bf16_t*)(C.ldsg + GL_VT); bf16_t* STs = (bf16_t*)(C.ldsg + GL_ST); bf16_t* Pm = (bf16_t*)(C.ldsg + GL_PM);
    float* Ob = (float*)(C.ldsg + GL_OB);
    float* Gt = (float*)(C.ldsg + GL_GT);
    for (int i = tid; i < 128 * GL_LD / 2; i += NTHR) ((unsigned*)STs)[i] = 0u;
    f32x16 st;
#pragma unroll
    for (int i = 0; i < 16; ++i) st[i] = 0.f;
    const float* gng = C.in[IN_GNG] + l * 128;
    const size_t hb = (size_t)bh * S_;
    const int bi = tid >> 3, e16 = (tid & 7) * 16;
    const int li = tid & 63, ld8 = (tid >> 6) * 8, le16 = (tid >> 6) * 16;
    const int pd = tid & 63, pg = tid >> 6;
    u32x4 nq = *(const u32x4*)(((const bf16_t*)(C.ws + WS_GQ)) + (hb + li) * 64 + ld8), nk = *(const u32x4*)(((const bf16_t*)(C.ws + WS_GK)) + (hb + li) * 64 + ld8);
    u32x4 nv0 = *(const u32x4*)(((const bf16_t*)(C.ws + WS_GV)) + (hb + li) * 128 + le16), nv1 = *(const u32x4*)(((const bf16_t*)(C.ws + WS_GV)) + (hb + li) * 128 + le16 + 8);
    float nla[8];
#pragma unroll
    for (int i = 0; i < 8; ++i) nla[i] = ((const float*)(C.ws + WS_LA))[(hb + 8 * pg + i) * 64 + pd];
    __syncthreads();
    for (int c = 0; c < S_ / 64; ++c) {
        const size_t tb = hb + c * 64;
        const u32x4 uq = nq, uk = nk, v0 = nv0, v1 = nv1;
        float lp[8]; { float run = 0.f;
#pragma unroll
            for (int i = 0; i < 8; ++i) { run += nla[i]; lp[i] = run; }
            Gt[pg * 64 + pd] = run; }
        const u32x4 g0 = *(const u32x4*)(((const bf16_t*)(C.ws + WS_GG)) + (tb + bi) * 128 + e16), g1 = *(const u32x4*)(((const bf16_t*)(C.ws + WS_GG)) + (tb + bi) * 128 + e16 + 8);
        if (c + 1 < S_ / 64) { const size_t tn = tb + 64;
            nq = *(const u32x4*)(((const bf16_t*)(C.ws + WS_GQ)) + (tn + li) * 64 + ld8); nk = *(const u32x4*)(((const bf16_t*)(C.ws + WS_GK)) + (tn + li) * 64 + ld8);
            nv0 = *(const u32x4*)(((const bf16_t*)(C.ws + WS_GV)) + (tn + li) * 128 + le16); nv1 = *(const u32x4*)(((const bf16_t*)(C.ws + WS_GV)) + (tn + li) * 128 + le16 + 8);
#pragma unroll
            for (int i = 0; i < 8; ++i) nla[i] = ((const float*)(C.ws + WS_LA))[(tn + 8 * pg + i) * 64 + pd]; }
        __syncthreads();
        { float off = 0.f;
#pragma unroll
          for (int g = 0; g < 7; ++g) off += (g < pg) ? Gt[g * 64 + pd] : 0.f;
#pragma unroll
          for (int i = 0; i < 8; ++i) Bc[(8 * pg + i) * GL_BS + pd] = off + lp[i]; }
        __syncthreads();
        { const int i = li, d8 = ld8, e16b = le16;
          float q[8], k[8];
#pragma unroll
          for (int e = 0; e < 4; ++e) { q[2 * e] = lo16(uq[e]); q[2 * e + 1] = hi16(uq[e]); k[2 * e] = lo16(uk[e]); k[2 * e + 1] = hi16(uk[e]); }
          float qt[8], kt[8];
#pragma unroll
          for (int e = 0; e < 8; ++e) { const float bb = Bc[i * GL_BS + d8 + e], bl = Bc[63 * GL_BS + d8 + e];
              qt[e] = q[e] * 0.125f * __expf(bb); kt[e] = k[e] * __expf(-bb); KhT[(d8 + e) * GL_LD + i] = f2bf(k[e] * __expf(bl - bb)); }
          u32x4 wq, wk;
#pragma unroll
          for (int e = 0; e < 4; ++e) { wq[e] = pk2(qt[2 * e], qt[2 * e + 1]); wk[e] = pk2(kt[2 * e], kt[2 * e + 1]); }
          *(u32x4*)(Qt + i * GL_LD + d8) = wq; *(u32x4*)(Kt + i * GL_LD + d8) = wk;
#pragma unroll
          for (int e = 0; e < 4; ++e) { VTs[(e16b + 2 * e) * GL_LD + i] = (bf16_t)(v0[e] & 0xffffu); VTs[(e16b + 2 * e + 1) * GL_LD + i] = (bf16_t)(v0[e] >> 16);
              VTs[(e16b + 8 + 2 * e) * GL_LD + i] = (bf16_t)(v1[e] & 0xffffu); VTs[(e16b + 8 + 2 * e + 1) * GL_LD + i] = (bf16_t)(v1[e] >> 16); } }
        __syncthreads();
        if (w < 4) { const int ti = w >> 1, tj = w & 1; f32x16 a;
#pragma unroll
            for (int i = 0; i < 16; ++i) a[i] = 0.f;
            if (!(ti == 0 && tj == 1)) {
#pragma unroll
                for (int s = 0; s < 4; ++s) a = MFMA32(ldfrag(C.lds, GL_QT, 32 * ti, 16 * s, lane), ldfrag(C.lds, GL_KT, 32 * tj, 16 * s, lane), a); }
#pragma unroll
            for (int i = 0; i < 16; ++i) { const int ii = 32 * ti + crow(i, hh), jj = 32 * tj + r; Pm[ii * GL_LD + jj] = f2bf(jj <= ii ? a[i] : 0.f); } }
        { const int te = w >> 1, td = w & 1; const float dl = __expf(Bc[63 * GL_BS + 32 * td + r]);
#pragma unroll
          for (int i = 0; i < 16; ++i) st[i] *= dl;
#pragma unroll
          for (int s = 0; s < 4; ++s) st = MFMA32(ldfrag(C.lds, GL_VT, 32 * te, 16 * s, lane), ldfrag(C.lds, GL_KHT, 32 * td, 16 * s, lane), st); }
        __syncthreads();
        { const int ti = w >> 2, te = w & 3; f32x16 a;
#pragma unroll
          for (int i = 0; i < 16; ++i) a[i] = 0.f;
#pragma unroll
          for (int s = 0; s < 4; ++s) a = MFMA32(ldfrag(C.lds, GL_PM, 32 * ti, 16 * s, lane), ldfrag(C.lds, GL_VT, 32 * te, 16 * s, lane), a);
#pragma unroll
          for (int s = 0; s < 4; ++s) a = MFMA32(ldfrag(C.lds, GL_QT, 32 * ti, 16 * s, lane), ldfrag(C.lds, GL_ST, 32 * te, 16 * s, lane), a);
#pragma unroll
          for (int i = 0; i < 16; ++i) Ob[(32 * ti + crow(i, hh)) * 132 + 32 * te + r] = a[i]; }
        __syncthreads();
        { const int te = w >> 1, td = w & 1;
#pragma unroll
          for (int i = 0; i < 16; ++i) STs[(32 * te + crow(i, hh)) * GL_LD + 32 * td + r] = f2bf(st[i]); }
        { const int i = bi; float o[16]; float ss = 0.f;
#pragma unroll
          for (int q = 0; q < 4; ++q) { const f32x4 x = *(const f32x4*)(Ob + i * 132 + e16 + 4 * q); o[4 * q] = x[0]; o[4 * q + 1] = x[1]; o[4 * q + 2] = x[2]; o[4 * q + 3] = x[3]; ss += x[0] * x[0] + x[1] * x[1] + x[2] * x[2] + x[3] * x[3]; }
          ss = sum8(ss);
          const float rstd = rsqrtf(ss * (1.f / 128.f) + 1e-6f);
          float gt[16];
#pragma unroll
          for (int e = 0; e < 4; ++e) { gt[2 * e] = lo16(g0[e]); gt[2 * e + 1] = hi16(g0[e]); gt[8 + 2 * e] = lo16(g1[e]); gt[8 + 2 * e + 1] = hi16(g1[e]); }
#pragma unroll
          for (int e = 0; e < 16; ++e) o[e] = o[e] * rstd * gng[e16 + e] * siluf_(gt[e]);
          u32x4 w0, w1;
#pragma unroll
          for (int e = 0; e < 4; ++e) { w0[e] = pk2(o[2 * e], o[2 * e + 1]); w1[e] = pk2(o[8 + 2 * e], o[8 + 2 * e + 1]); }
          bf16_t* dst = ((bf16_t*)(C.ws + WS_OG)) + ((size_t)(bh >> 2) * S_ + c * 64 + i) * 512 + h * 128 + e16;
          *(u32x4*)dst = w0; *(u32x4*)(dst + 8) = w1; }
        __syncthreads();
    }
}

constexpr int AT_Q = 0, AT_K = 65536, AT_V = 65536 + 18432, AT_KLD = 72, AT_VLD = 36;
__device__ __forceinline__ void attn_wg(const Ctx& C0, int l, int bh, int jb, float lam, float lam_init) {
    Ctx C = C0; fresh(C);
    const int b = bh >> 2, h = bh & 3, tid = C.tid, lane = C.lane, r = lane & 31, hh = lane >> 5, j = 8 * jb + C.wave;
    LAS bf16x8* qs = (LAS bf16x8*)(C.lds + AT_Q + C.wave * 8192) + lane;
#pragma unroll
    for (int cc = 0; cc < 2; ++cc)
#pragma unroll
        for (int s = 0; s < 4; ++s) qs[64 * (cc * 4 + s)] = *(const bf16x8*)(((const bf16_t*)(C.ws + WS_QH)) + (((size_t)b * 8 + h * 2 + cc) * S_ + 32 * j + r) * 64 + 16 * s + 8 * hh);
    f32x16 O[2][4];
#pragma unroll
    for (int cc = 0; cc < 2; ++cc)
#pragma unroll
        for (int k = 0; k < 4; ++k)
#pragma unroll
            for (int i = 0; i < 16; ++i) O[cc][k][i] = 0.f;
    float mrun[2] = {-INFINITY, -INFINITY}, lsum[2] = {0.f, 0.f};
    const float slope = exp2f(-2.f * (float)(h + 1));
    const int qpos = 32 * j + r;
    const int kcc = tid >> 8, kkey = (tid >> 3) & 31, kc = tid & 7, ve = tid >> 2, vc = tid & 3;
    const bf16_t* kg = ((const bf16_t*)(C.ws + WS_KH)) + (((size_t)b * 8 + h * 2 + kcc) * S_ + kkey) * 64 + 8 * kc;
    const bf16_t* vg = ((const bf16_t*)(C.ws + WS_VT)) + (((size_t)b * 4 + h) * 64) * 4096 + ve * 32 + 8 * vc;
    const int klo = AT_K + ((kcc * 32 + kkey) * AT_KLD + 8 * kc) * 2, vlo = AT_V + (ve * AT_VLD + 8 * vc) * 2;
    const int ntiles = 8 * jb + 8;
    u32x4 kreg = *(const u32x4*)kg, vreg = *(const u32x4*)vg;
    for (int kt = 0; kt < ntiles; ++kt) {
        const int boff = (kt & 1) * 9216;
        *(LAS u32x4*)(C.lds + klo + boff) = kreg;
        { LAS u32x2* vd = (LAS u32x2*)(C.lds + vlo + boff); u32x2 a, c2; a.x = vreg.x; a.y = vreg.y; c2.x = vreg.z; c2.y = vreg.w; vd[0] = a; vd[1] = c2; }
        if (kt + 1 < ntiles) { kreg = *(const u32x4*)(kg + (size_t)(kt + 1) * 32 * 64); vreg = *(const u32x4*)(vg + (size_t)(kt + 1) * 4096); }
        __syncthreads();
        if (kt <= j) {
            const LAS unsigned char* kb = C.lds + AT_K + boff; const LAS unsigned char* vb = C.lds + AT_V + boff;
#pragma unroll
            for (int cc = 0; cc < 2; ++cc) {
                f32x16 sc;
#pragma unroll
                for (int i = 0; i < 16; ++i) sc[i] = 0.f;
#pragma unroll
                for (int s = 0; s < 4; ++s) { const bf16x8 kf = *(const LAS bf16x8*)(kb + ((cc * 32 + r) * AT_KLD + 16 * s + 8 * hh) * 2); sc = MFMA32(kf, qs[64 * (cc * 4 + s)], sc); }
                float mx = -INFINITY;
#pragma unroll
                for (int i = 0; i < 16; ++i) { const int dist = qpos - (32 * kt + crow(i, hh)); float v = sc[i] - slope * (float)dist; v = (dist < 0) ? -INFINITY : v; sc[i] = v; mx = fmaxf(mx, v); }
                mx = fmaxf(mx, xor32(mx, lane));
                const float mnew = fmaxf(mrun[cc], mx);
                float ps = 0.f;
#pragma unroll
                for (int i = 0; i < 16; ++i) { const float p = __expf(sc[i] - mnew); sc[i] = p; ps += p; }
                ps += xor32(ps, lane);
                if (__any(mnew > mrun[cc])) {
                    const float alpha = __expf(mrun[cc] - mnew);
                    lsum[cc] *= alpha;
#pragma unroll
                    for (int k = 0; k < 4; ++k)
#pragma unroll
                        for (int i = 0; i < 16; ++i) O[cc][k][i] *= alpha;
                }
                lsum[cc] += ps; mrun[cc] = mnew;
                bf16x8 pb[2];
#pragma unroll
                for (int s2 = 0; s2 < 2; ++s2) { u32x4 t; t.x = pk2(sc[8 * s2], sc[8 * s2 + 1]); t.y = pk2(sc[8 * s2 + 2], sc[8 * s2 + 3]); t.z = pk2(sc[8 * s2 + 4], sc[8 * s2 + 5]); t.w = pk2(sc[8 * s2 + 6], sc[8 * s2 + 7]); pb[s2] = __builtin_bit_cast(bf16x8, t); }
#pragma unroll
                for (int k = 0; k < 4; ++k)
#pragma unroll
                    for (int s2 = 0; s2 < 2; ++s2) { const LAS unsigned char* vp = vb + ((32 * k + r) * AT_VLD + 16 * s2 + 4 * hh) * 2;
                        const u32x2 lo = *(const LAS u32x2*)vp, hi = *(const LAS u32x2*)(vp + 16);
                        u32x4 t; t.x = lo.x; t.y = lo.y; t.z = hi.x; t.w = hi.y;
                        O[cc][k] = MFMA32(__builtin_bit_cast(bf16x8, t), pb[s2], O[cc][k]); }
                __builtin_amdgcn_sched_barrier(0);
            }
        }
    }
    const float i1 = 1.f / lsum[0], i2 = lam / lsum[1];
    float ss = 0.f;
#pragma unroll
    for (int k = 0; k < 4; ++k)
#pragma unroll
        for (int i = 0; i < 16; ++i) { const float o = O[0][k][i] * i1 - O[1][k][i] * i2; O[0][k][i] = o; ss += o * o; }
    ss += xor32(ss, lane);
    const float rs = rsqrtf(ss * (1.f / 128.f) + 1e-6f) * (1.f - lam_init);
    const float* sg = C.in[IN_SUBLN] + l * 128;
    bf16_t* dst = ((bf16_t*)(C.ws + WS_OA)) + (size_t)(b * S_ + 32 * j + r) * 512 + h * 128;
#pragma unroll
    for (int k = 0; k < 4; ++k)
#pragma unroll
        for (int g = 0; g < 4; ++g) { const int dv = 32 * k + 8 * g + 4 * hh; const f32x4 gg = *(const f32x4*)(sg + dv);
            u32x2 w; w.x = pk2(O[0][k][4 * g] * rs * gg[0], O[0][k][4 * g + 1] * rs * gg[1]); w.y = pk2(O[0][k][4 * g + 2] * rs * gg[2], O[0][k][4 * g + 3] * rs * gg[3]);
            *(u32x2*)(dst + dv) = w; }
    __syncthreads();
}

__device__ __forceinline__ void gate_units(const Ctx& C0, int l) {
    Ctx C = C0; fresh(C);
    __syncthreads();
    GateOrder S; S.A = (const char*)(C.ws + WS_H); S.B = (const char*)(((const bf16_t*)(C.ws + WS_WIN)) + (size_t)l * NP_ * 1024); { const int a = C.bid - 128; S.q = (a & 7) * 16 + (a >> 3); }
    EpiP E{C.ws};
    pg8::gemm_phase<EpiP, GateOrder, false>(C.lds, C.tid, 1024, 2048u, 2048u, S, E);
}
__device__ __forceinline__ void phase_mixers(const Ctx& C, int l) {
#ifndef REP_R
#define REP_R 1
#define REP_G 1
#define REP_A 1
#endif
    if (C.bid < 128) { for (int rep = 0; rep < REP_R; ++rep) rwkv_wg(C, l, C.bid); return; }
    if (C.bid < 160) { for (int rep = 0; rep < REP_G; ++rep) gla_wg(C, l, C.bid - 128); gate_units(C, l); return; }
    const float lam_init = 0.8f - 0.6f * __expf(-0.3f * (float)l);
    const float* lv = C.in[IN_LAM] + l * 256;
    const float d0 = wave_sum(lv[C.lane] * lv[64 + C.lane]), d1 = wave_sum(lv[128 + C.lane] * lv[192 + C.lane]);
    const float lam = __expf(d0) - __expf(d1) + lam_init;
    {
        const int a = C.bid - 160, grp = a >> 5, bh = a & 31;
        for (int rep = 0; rep < REP_A; ++rep) {
            if (grp == 0) { attn_wg(C, l, bh, 7, lam, lam_init); attn_wg(C, l, bh, 3, lam, lam_init); }
            else if (grp == 1) { attn_wg(C, l, bh, 6, lam, lam_init); attn_wg(C, l, bh, 4, lam, lam_init); }
            else { attn_wg(C, l, bh, 5, lam, lam_init); attn_wg(C, l, bh, 2, lam, lam_init); attn_wg(C, l, bh, 1, lam, lam_init); attn_wg(C, l, bh, 0, lam, lam_init); }
        }
    }
    gate_units(C, l);
}

__device__ __forceinline__ int rcount_of(int wave, int bid, int G) { const int gw = bid * NWAVES + wave, NGW = G * NWAVES; return gw < T_ ? (T_ - 1 - gw) / NGW + 1 : 0; }
__device__ __forceinline__ void phase_route(const Ctx& C, int l) {
    float* rw = (float*)C.ldsg;
    { const float* gw_ = C.in[IN_RGW] + (size_t)l * 1024 * 4; const float* ew = C.in[IN_REW] + (size_t)l * 1024 * 32;
#pragma unroll 8
      for (int i = C.tid; i < 1024 * 8; i += NTHR) { const int k = i >> 3, o4 = (i & 7) * 4; *(f32x4*)(rw + k * 36 + 4 + o4) = *(const f32x4*)(ew + 4 * i); }
#pragma unroll
      for (int i = C.tid; i < 1024; i += NTHR) *(f32x4*)(rw + i * 36) = *(const f32x4*)(gw_ + 4 * i); }
    __syncthreads();
    const int gw = C.bid * NWAVES + C.wave, NGW = C.G * NWAVES, lane = C.lane;
    int* rr_e = (int*)(C.ldsg + 147456); float* rr_w = (float*)(C.ldsg + 147456 + 512); int* rr_t = (int*)(C.ldsg + 147456 + 1024);
    int* lcnt = (int*)(C.ldsg + 147456 + 1280); int* lbase = (int*)(C.ldsg + 147456 + 1408);
    float* gmv = (float*)(C.ldsg + 149504); float* shv = gmv + 1024;
    int rcount = 0;
    for (int slab = C.bid; slab < T_ / 64; slab += C.G) {
        const int b = (64 * slab) >> 11; const float* md = ((float*)(C.ws + WS_MOD)) + ((size_t)l * 8 + b) * 6144;
        __syncthreads();
        for (int k = C.tid; k < 1024; k += NTHR) { gmv[k] = C.in[IN_N2G][l * 1024 + k] * (1.f + md[4096 + k]); shv[k] = md[3072 + k]; }
        __syncthreads();
#pragma unroll 1
      for (int rw8 = 0; rw8 < 8; ++rw8) {
        const int t = 64 * slab + 8 * C.wave + rw8; const float* xr = C.out + (size_t)t * 1024;
        float ss = 0.f;
#pragma unroll
        for (int i = 0; i < 16; ++i) { const float xv = xr[lane + 64 * i]; ss += xv * xv; }
        ss = wave_sum(ss);
        const float rstd = rsqrtf(ss * (1.f / 1024.f) + 1e-6f);
        float acc[36];
#pragma unroll
        for (int o = 0; o < 36; ++o) acc[o] = 0.f;
        float n0 = xr[lane], n1 = xr[lane + 64];
#pragma unroll 1
        for (int i = (C.flags & 4) ? 16 : 0; i < 16; i += 2) {
            const float c0 = n0, c1 = n1;
            if (i + 2 < 16) { n0 = xr[lane + 64 * (i + 2)]; n1 = xr[lane + 64 * (i + 3)]; }
#pragma unroll
            for (int u = 0; u < 2; ++u) { const int k = lane + 64 * (i + u);
                const float h2 = (u ? c1 : c0) * rstd * gmv[k] + shv[k];
                ((bf16_t*)(C.ws + WS_H))[(size_t)t * 1024 + k] = f2bf(h2);
                const float* wr_ = rw + k * 36;
#pragma unroll
                for (int q = 0; q < 9; ++q) { const f32x4 wv = *(const f32x4*)(wr_ + 4 * q); acc[4 * q] += h2 * wv[0]; acc[4 * q + 1] += h2 * wv[1]; acc[4 * q + 2] += h2 * wv[2]; acc[4 * q + 3] += h2 * wv[3]; } }
        }
        int grp = 0, i0 = 0, i1 = 1; float w0 = 0.f, w1 = 0.f;
        if (!(C.flags & 8)) {
#pragma unroll
        for (int o = 0; o < 36; ++o) acc[o] = wave_sum(acc[o]) + ((o < 4) ? C.in[IN_RGB][l * 4 + o] : C.in[IN_REB][l * 32 + o - 4]);
        grp = 0; float gm = acc[0];
#pragma unroll
        for (int g = 1; g < 4; ++g) if (acc[g] > gm) { gm = acc[g]; grp = g; }
        float gsum = 0.f;
#pragma unroll
        for (int g = 0; g < 4; ++g) gsum += __expf(acc[g] - gm);
        const float gprob = 1.f / gsum;
        float ev[8];
        const float mg0 = (grp == 0) ? 1.f : 0.f, mg1 = (grp == 1) ? 1.f : 0.f, mg2 = (grp == 2) ? 1.f : 0.f, mg3 = (grp == 3) ? 1.f : 0.f;
#pragma unroll
        for (int e = 0; e < 8; ++e) ev[e] = mg0 * acc[4 + e] + mg1 * acc[12 + e] + mg2 * acc[20 + e] + mg3 * acc[28 + e];
        i0 = 0; float v0 = ev[0];
#pragma unroll
        for (int e = 1; e < 8; ++e) if (ev[e] > v0) { v0 = ev[e]; i0 = e; }
        i1 = -1; float v1 = -INFINITY;
#pragma unroll
        for (int e = 0; e < 8; ++e) if (e != i0 && ev[e] > v1) { v1 = ev[e]; i1 = e; }
        const float e1 = __expf(v1 - v0), den = 1.f / (1.f + e1);
        w0 = gprob * den; w1 = gprob * e1 * den;
        }
        if (lane == 0) {
            const int ri = C.wave * 8 + rcount;
            rr_e[2 * ri] = grp * 8 + i0; rr_e[2 * ri + 1] = grp * 8 + i1; rr_w[2 * ri] = w0; rr_w[2 * ri + 1] = w1; rr_t[ri] = t;
        }
        ++rcount;
      }
    }
    __syncthreads();
    if (C.tid < 32) lcnt[C.tid] = 0;
    __syncthreads();
    int my_e = -1, my_lp = 0, my_slot = 0; float my_w = 0.f;
    if (C.tid < 128 && !(C.flags & 1)) { const int ri = C.tid >> 1, k = C.tid & 1;
        if ((ri & 7) < rcount) { my_e = rr_e[C.tid]; my_w = rr_w[C.tid]; my_slot = 2 * rr_t[ri] + k; my_lp = atomicAdd(&lcnt[my_e], 1); } }
    __syncthreads();
    if (C.tid < 32) { const int n = lcnt[C.tid]; lbase[C.tid] = n ? (int)atomicAdd(((unsigned*)(C.ws + WS_CTL)) + CW_CNT + l * 2048 + 64 * C.tid, (unsigned)n) : 0; }
    __syncthreads();
    if (my_e >= 0) { const size_t o = (size_t)my_e * ECAP + lbase[my_e] + my_lp; ((int*)(C.ws + WS_LIST))[o] = my_slot; ((float*)(C.ws + WS_WL))[o] = my_w; }
    __syncthreads();
    LAS float* scr = (LAS float*)(C.lds + C.wave * 8448);
    constexpr int I_GU = 32 * 16 * 32, I_DN = 32 * 8 * 32;
    for (int it = (C.flags & 2) ? I_GU + I_DN : gw; it < I_GU + I_DN; it += NGW) {
        if (it < I_GU) { const int e = it / 512, q = it % 512, kb = q / 32, nb = q % 32, n0 = 32 * nb;
            const int up = (n0 >> 7) & 1, col = (n0 >> 8) * 128 + (n0 & 127);
            const float* src = C.in[up ? IN_EU : IN_EG] + ((size_t)(l * 32 + e) * 1024 + 64 * kb) * 512;
            transpose_item(src, 512, col, 32, ((bf16_t*)(C.ws + WS_WGU)) + (size_t)e * 1024 * 1024, 1024, n0, 64 * kb, scr, lane);
        } else { const int r = it - I_GU, e = r / 256, q = r % 256, kb = q / 32, nb = q % 32;
            const float* src = C.in[IN_ED] + ((size_t)(l * 32 + e) * 512 + 64 * kb) * 1024;
            transpose_item(src, 1024, 32 * nb, 32, ((bf16_t*)(C.ws + WS_WD)) + (size_t)e * 1024 * 512, 512, 32 * nb, 64 * kb, scr, lane); }
    }
}
constexpr int NPHASE = 22;
#ifndef PHMASK
#define PHMASK 0x7ff
#endif
#define EN(n) ((PHMASK >> (n)) & 1)
#define IN(k) (lo <= (k) && (k) < hi)
#ifndef XBAR_REP
#define XBAR_REP 1
#endif
#define SEAM(k) do { if (IN((k) + 1)) for (int xb_ = 0; xb_ < XBAR_REP; ++xb_) xcd_barrier(bar); } while (0)
#ifndef REP_PRO
#define REP_PRO 1
#define REP_WIN 1
#define REP_MRG 1
#define REP_UP 1
#define REP_DN 1
#define REP_ROW0 1
#endif
template <int L> __device__ __forceinline__ void run_layer(Ctx& C, const int lo, const int hi, const XcdBarrier& bar) {
    const int l = L;
        const int pb = 1 + 10 * l;
        if (EN(1) && IN(pb + 0)) { fresh(C); phase_rows(C, l, (l > 0 ? 1 : 0) | 2); if (l == 0) for (int rep = 1; rep < REP_ROW0; ++rep) phase_rows(C, l, 2); SEAM(pb + 0); }
        if (EN(2) && IN(pb + 1)) { fresh(C);
            WinOrder S; S.A = (const char*)(C.ws + WS_H); S.B = (const char*)(((const bf16_t*)(C.ws + WS_WIN)) + (size_t)l * NP_ * 1024); S.G = C.G; S.c = C.bid;
            EpiP E{C.ws};
            for (int rep = 0; rep < REP_WIN; ++rep) pg8::gemm_phase<EpiP, WinOrder, false>(C.lds, C.tid, 1024, 2048u, 2048u, S, E);
            SEAM(pb + 1);
        }
        if (EN(3) && IN(pb + 2)) { fresh(C); phase_prep(C, l); SEAM(pb + 2); }
        if (EN(4) && IN(pb + 3)) { fresh(C); phase_mixers(C, l); SEAM(pb + 3); }
        if (EN(5) && IN(pb + 4)) { fresh(C); rwkv_finish(C, l); SEAM(pb + 4); }
        if (EN(6) && IN(pb + 5)) { fresh(C);
            MergeOrder S; S.O0 = ((bf16_t*)(C.ws + WS_OA)); S.O1 = ((bf16_t*)(C.ws + WS_OR)); S.O2 = ((bf16_t*)(C.ws + WS_OG)); S.W = ((bf16_t*)(C.ws + WS_WPROJ)) + (size_t)l * 3 * 1024 * 512; S.G = C.G; S.c = C.vcu;
            EpiMerge E{((bf16_t*)(C.ws + WS_GATES)), ((bf16_t*)(C.ws + WS_H))};
            for (int rep = 0; rep < REP_MRG; ++rep) pg8::gemm_phase<EpiMerge, MergeOrder, false>(C.lds, C.tid, 512, 1024u, 1024u, S, E);
            SEAM(pb + 5);
        }
        if (EN(7) && IN(pb + 6)) { fresh(C);
            pg8::DenseOrder S; S.init(((bf16_t*)(C.ws + WS_H)), ((bf16_t*)(C.ws + WS_WOUT)) + (size_t)l * 1024 * 1024, 2048u, 2048u, T_, 1024, C.G, C.bid);
            EpiOut E{l == 0 ? C.in[IN_X] : C.out, C.out, ((float*)(C.ws + WS_MOD)) + (size_t)l * 8 * 6144 + 2048};
            pg8::gemm_phase<EpiOut, pg8::DenseOrder, false>(C.lds, C.tid, 1024, 2048u, 2048u, S, E);
            SEAM(pb + 6);
        }
        if (EN(8) && IN(pb + 7)) { fresh(C); phase_route(C, l); SEAM(pb + 7); }
        if (EN(9) && IN(pb + 8)) { fresh(C);
            moe_build_table(C, l);
            unsigned* done = ((unsigned*)(C.ws + WS_CTL)) + CW_TD + 8192 * l;
            if (!(C.flags & 256)) { MoeOrder S; S.tab = (const LAS int*)(C.lds + LDS_SCHED); S.A = (const char*)((bf16_t*)(C.ws + WS_H)); S.B = (const char*)((bf16_t*)(C.ws + WS_WGU)); S.LIST = ((int*)(C.ws + WS_LIST)); S.WL = ((float*)(C.ws + WS_WL)); S.G = C.G; S.c = C.vcu; S.down = 0; S.done = done;
              EpiHid E{((bf16_t*)(C.ws + WS_HID)), done};
              pg8::gemm_phase<EpiHid, MoeOrder, true>(C.lds, C.tid, 1024, 2048u, 2048u, S, E); }
            if (!(C.flags & 512)) { MoeOrder S; S.tab = (const LAS int*)(C.lds + LDS_SCHED); S.A = (const char*)((bf16_t*)(C.ws + WS_HID)); S.B = (const char*)((bf16_t*)(C.ws + WS_WD)); S.LIST = ((int*)(C.ws + WS_LIST)); S.WL = ((float*)(C.ws + WS_WL)); S.G = C.G; S.c = C.vcu; S.down = 1; S.done = done;
              EpiDown E{((bf16_t*)(C.ws + WS_YS))};
              pg8::gemm_phase<EpiDown, MoeOrder, false>(C.lds, C.tid, 512, 1024u, 1024u, S, E); }
            SEAM(pb + 9);
        }
    }
__global__ void __launch_bounds__(NTHR, 2) hybrid_fwd(Args args) {
    extern __shared__ __attribute__((aligned(16))) unsigned char lds_raw[];
    Ctx C;
    C.in = args.in; C.out = args.out; C.ws = args.ws; C.ws0 = args.ws;
    C.ldsg = lds_raw; C.lds = (LAS unsigned char*)lds_raw;
    C.flags = args.flags; C.tid = threadIdx.x; C.lane = C.tid & 63; C.wave = __builtin_amdgcn_readfirstlane(C.tid >> 6); C.G = gridDim.x; C.bid = blockIdx.x;
    C.vcu = (C.G % 8 == 0) ? (C.bid % 8) * (C.G / 8) + C.bid / 8 : C.bid;
    volatile LAS unsigned* bst = (volatile LAS unsigned*)(C.lds + LDS_CTL);
    if (C.tid < 4) bst[C.tid] = 0u;
    __syncthreads();
    const int lo = args.ph_lo, hi = args.ph_hi;
    const bool multi = (hi - lo) > 1;
    XcdBarrier bar; bar.bar = ((unsigned*)(C.ws + WS_CTL)) + CW_BAR; bar.x = 0; bar.st = bst;
    if (multi) bar = xcd_barrier_post(((unsigned*)(C.ws + WS_CTL)) + CW_BAR, bst);

    if (EN(0) && IN(0)) { fresh(C); for (int rep = 0; rep < REP_PRO; ++rep) phase_prologue(C); SEAM(0); }
    run_layer<0>(C, lo, hi, bar);
    run_layer<1>(C, lo, hi, bar);
    if (IN(21)) { fresh(C); phase_rows(C, 2, 1); }
}

#ifndef N_LAUNCH_MODE
#define N_LAUNCH_MODE 1
#endif
extern "C" void kernel_launch(void* const* d_in, const int* in_sizes, int n_in, void* d_out, int out_size, void* d_ws, size_t ws_size, hipStream_t stream) {
    static int grid = 0;
    if (grid == 0) {
        if (n_in != 36 || out_size != T_ * D_ || ws_size < WS_END) { fprintf(stderr, "kernel_launch: unexpected problem (n_in %d, out %d, ws %zu < %zu)\n", n_in, out_size, ws_size, (size_t)WS_END); grid = -1; return; }
        int dev = 0, cus = 0, per_cu = 0;
        if (hipGetDevice(&dev) != hipSuccess || hipDeviceGetAttribute(&cus, hipDeviceAttributeMultiprocessorCount, dev) != hipSuccess) { grid = -1; return; }
        if (hipFuncSetAttribute((const void*)hybrid_fwd, hipFuncAttributeMaxDynamicSharedMemorySize, LDS_BYTES) != hipSuccess) { fprintf(stderr, "kernel_launch: hipFuncSetAttribute failed\n"); grid = -1; return; }
        if (hipOccupancyMaxActiveBlocksPerMultiprocessor(&per_cu, (const void*)hybrid_fwd, NTHR, LDS_BYTES) != hipSuccess || per_cu < 1) fprintf(stderr, "kernel_launch: occupancy query says %d\n", per_cu);
        (void)hipGetLastError();
        if (cus < 256) { fprintf(stderr, "kernel_launch: needs 256 CUs, device has %d\n", cus); grid = -1; return; }
        grid = 256;
    }
    if (grid < 0) return;
    (void)hipMemsetAsync((char*)d_ws + WS_CTL, 0, CTL_BYTES, stream);
    Args a{};
    for (int i = 0; i < 36; ++i) a.in[i] = (const float*)d_in[i];
    a.out = (float*)d_out; a.ws = (unsigned char*)d_ws;
#if N_LAUNCH_MODE == 1
    a.ph_lo = 0; a.ph_hi = NPHASE;
    hipLaunchKernelGGL(hybrid_fwd, dim3(grid), dim3(NTHR), LDS_BYTES, stream, a);
#else
#ifndef HREP_LIST
#define HREP_LIST 1,1,1,1,1,1,1,1,1,1,1,1,1,1,1,1,1,1,1,1,1,1
#endif
    static const int hrep[NPHASE] = {HREP_LIST};
#ifndef HREP_FLAGS
#define HREP_FLAGS 3
#endif
    for (int p = 0; p < NPHASE; ++p) for (int r = 0; r < hrep[p]; ++r) { a.ph_lo = p; a.ph_hi = p + 1; a.flags = r ? HREP_FLAGS : 0; hipLaunchKernelGGL(hybrid_fwd, dim3(grid), dim3(NTHR), LDS_BYTES, stream, a); }
#endif
}
```

```cpp
#include <hip/hip_runtime.h>
#include <cstdio>
#include <cstdint>

#define LAS __attribute__((address_space(3)))
typedef unsigned short bf16_t;
typedef short bf16x8 __attribute__((ext_vector_type(8)));
typedef float f32x4 __attribute__((ext_vector_type(4)));
typedef float f32x16 __attribute__((ext_vector_type(16)));
typedef unsigned u32x4 __attribute__((ext_vector_type(4)));
typedef unsigned u32x2 __attribute__((ext_vector_type(2)));

constexpr int T_ = 16384, D_ = 1024, S_ = 2048, NB_ = 8, NP_ = 8192, NIN_ = 7952;
constexpr int ECAP = 16384;
constexpr int NWAVES = 8, NTHR = 512;
constexpr int LDS_BYTES = 163840, LDS_CTL = LDS_BYTES - 256, LDS_SCHED = 131072;

constexpr size_t MiB = 1u << 20;
constexpr size_t WS_CTL = 0, CTL_BYTES = 256 * 1024;
constexpr size_t WS_MOD = 1 * MiB, WS_LW = WS_MOD + 512 * 1024;
constexpr size_t WS_WIN = 2 * MiB, WS_WPROJ = 34 * MiB, WS_WOUT = 40 * MiB;
constexpr size_t WS_H = 44 * MiB, WS_OA = 76 * MiB, WS_OR = 92 * MiB, WS_OG = 108 * MiB, WS_VT = 124 * MiB;
constexpr size_t WS_RR = 140 * MiB, WS_RK = 156 * MiB, WS_RV = 172 * MiB, WS_RKK = 188 * MiB, WS_RBB = 204 * MiB, WS_RG = 220 * MiB, WS_RLD = 236 * MiB, WS_RBON = 268 * MiB;
constexpr size_t WS_LA = 270 * MiB, WS_P = 286 * MiB;
constexpr size_t WS_QH = WS_P, WS_KH = WS_P + 16 * MiB, WS_AV = WS_P + 32 * MiB, WS_RWS = WS_P + 48 * MiB, WS_GQ = WS_P + 104 * MiB, WS_GK = WS_P + 112 * MiB, WS_GV = WS_P + 120 * MiB, WS_GG = WS_P + 136 * MiB,
                 WS_GATES = WS_P + 152 * MiB, WS_GAD = WS_P + 248 * MiB;
constexpr size_t WS_RC = WS_RBON + 1 * MiB;
constexpr size_t WS_RY = WS_RWS;
constexpr size_t WS_WGU = WS_P, WS_WD = WS_P + 64 * MiB, WS_HID = WS_P + 96 * MiB, WS_YS = WS_P + 136 * MiB, WS_LIST = WS_P + 200 * MiB, WS_WL = WS_P + 202 * MiB;
constexpr size_t WS_END = WS_P + 256 * MiB;
constexpr int CW_BAR = 4096, CW_CNT = 16384, CW_TD = 32768;
constexpr int CW_DUMMY_ = 0;

__device__ __forceinline__ float bf2f(bf16_t v) { return __uint_as_float(((unsigned)v) << 16); }
__device__ __forceinline__ bf16_t f2bf(float f) { return __builtin_bit_cast(unsigned short, (__bf16)f); }
__device__ __forceinline__ unsigned pk2(float lo, float hi) { typedef __bf16 bf2 __attribute__((ext_vector_type(2))); bf2 v; v[0] = (__bf16)lo; v[1] = (__bf16)hi; return __builtin_bit_cast(unsigned, v); }
__device__ __forceinline__ float lo16(unsigned u) { return __uint_as_float(u << 16); }
__device__ __forceinline__ float hi16(unsigned u) { return __uint_as_float(u & 0xffff0000u); }
template <int CTRL> __device__ __forceinline__ float dppf(float v) { return __int_as_float(__builtin_amdgcn_mov_dpp(__float_as_int(v), CTRL, 0xF, 0xF, true)); }
__device__ __forceinline__ float sum8(float v) { v += dppf<0xB1>(v); v += dppf<0x4E>(v); v += dppf<0x141>(v); return v; }
__device__ __forceinline__ float sum16(float v) { v = sum8(v); v += dppf<0x140>(v); return v; }
__device__ __forceinline__ float wave_sum(float v) {
    v = sum16(v);
    const int i = __float_as_int(v);
    return (__int_as_float(__builtin_amdgcn_readlane(i, 0)) + __int_as_float(__builtin_amdgcn_readlane(i, 16))) + (__int_as_float(__builtin_amdgcn_readlane(i, 32)) + __int_as_float(__builtin_amdgcn_readlane(i, 48)));
}
__device__ __forceinline__ float xor32(float v, int lane) { return __int_as_float(__builtin_amdgcn_ds_bpermute((lane ^ 32) << 2, __float_as_int(v))); }
__device__ __forceinline__ float sigmoidf_(float x) { return 1.0f / (1.0f + __expf(-x)); }
__device__ __forceinline__ float siluf_(float x) { return x / (1.0f + __expf(-x)); }
__device__ __forceinline__ float softplusf_(float z) { return fmaxf(z, 0.f) + log1pf(__expf(-fabsf(z))); }
__device__ __forceinline__ int crow(int reg, int hh) { return (reg & 3) + 8 * (reg >> 2) + 4 * hh; }
#define MFMA32(a, b, c) __builtin_amdgcn_mfma_f32_32x32x16_bf16((a), (b), (c), 0, 0, 0)

#define XB_TMO      128
#define XB_XCNT(j)  (256  + 64 * (j))
#define XB_XSUB(j)  (1280 + 64 * (j))
#define XB_XGEN(j)  (2304 + 64 * (j))
#define XB_TOP      3328
#define XB_TOPGEN   3392
#define XCD_BAR_WORDS 3456
#define XB_SPIN_CAP (1u << 18)

__device__ __forceinline__ unsigned xb_ld(unsigned* p)              { return __hip_atomic_load(p, __ATOMIC_RELAXED, __HIP_MEMORY_SCOPE_AGENT); }
__device__ __forceinline__ unsigned xb_add(unsigned* p, unsigned v) { return __hip_atomic_fetch_add(p, v, __ATOMIC_RELAXED, __HIP_MEMORY_SCOPE_AGENT); }
__device__ __forceinline__ unsigned xb_xcc_id() { return (unsigned)__builtin_amdgcn_s_getreg((3 << 11) | 20) & 0xFu; }
#define XB_SPIN(cond, bar) do { unsigned _sp = 0; while (cond) { __builtin_amdgcn_s_sleep(1); \
    if ((++_sp & 255u) == 0u) { if (xb_ld(&(bar)[XB_TMO])) break; if (_sp > XB_SPIN_CAP) { atomicAdd(&(bar)[XB_TMO], 1u); break; } } } } while (0)

struct XcdBarrier { unsigned* bar; unsigned x; volatile LAS unsigned* st; };

__device__ __forceinline__ XcdBarrier xcd_barrier_post(unsigned* bar, volatile LAS unsigned* st) {
    XcdBarrier b; b.bar = bar; b.x = xb_xcc_id(); b.st = st;
    if (threadIdx.x == 0) (void)xb_add(&bar[XB_XCNT(b.x)], 1u);
    return b;
}
__device__ __forceinline__ void xcd_barrier_complete(unsigned* bar, unsigned x, unsigned& nloc, unsigned& nx) {
    const unsigned G = gridDim.x * gridDim.y * gridDim.z;
    unsigned sum, cnt, mine, sp = 0u;
    for (;;) {
        sum = 0u; cnt = 0u; mine = 0u;
#pragma unroll 1
        for (unsigned j = 0; j < 16; ++j) { const unsigned c = xb_ld(&bar[XB_XCNT(j)]); sum += c; cnt += (c > 0u) ? 1u : 0u; mine = (j == x) ? c : mine; }
        if (sum == G) break;
        __builtin_amdgcn_s_sleep(1);
        if ((++sp & 255u) == 0u) { if (xb_ld(&bar[XB_TMO])) break; if (sp > XB_SPIN_CAP) { atomicAdd(&bar[XB_TMO], 1u); break; } }
    }
    nloc = mine > 0u ? mine : 1u; nx = cnt > 0u ? cnt : 1u;
}
__device__ __forceinline__ void xcd_barrier(const XcdBarrier& b) {
    asm volatile("s_waitcnt vmcnt(0)" ::: "memory");
    __syncthreads();
    if (threadIdx.x == 0) {
        unsigned* bar = b.bar;
        __builtin_amdgcn_s_waitcnt(0);
        unsigned nloc = b.st[0], nx = b.st[1];
        if (nloc == 0u) { xcd_barrier_complete(bar, b.x, nloc, nx); b.st[0] = nloc; b.st[1] = nx; }
        const unsigned old = xb_add(&bar[XB_XSUB(b.x)], 1u);
        const unsigned gen = old / nloc;
        if (old + 1u == (gen + 1u) * nloc) {
            __builtin_amdgcn_fence(__ATOMIC_RELEASE, "agent");
            asm volatile("s_waitcnt vmcnt(0)" ::: "memory");
            const unsigned og = xb_add(&bar[XB_TOP], 1u);
            const unsigned tg = og / nx;
            if (og + 1u == (tg + 1u) * nx) xb_add(&bar[XB_TOPGEN], 1u);
            else XB_SPIN(xb_ld(&bar[XB_TOPGEN]) == tg, bar);
            __builtin_amdgcn_fence(__ATOMIC_ACQUIRE, "agent");
            xb_add(&bar[XB_XGEN(b.x)], 1u);
            asm volatile("s_waitcnt vmcnt(0)" ::: "memory");
        } else {
            XB_SPIN(xb_ld(&bar[XB_XGEN(b.x)]) == gen, bar);
            __builtin_amdgcn_fence(__ATOMIC_ACQUIRE, "agent");
            asm volatile("s_waitcnt vmcnt(0)" ::: "memory");
        }
    }
    __syncthreads();
}

#ifndef A_AUX_WAIT
#define A_AUX_WAIT 16
#endif
namespace pg8 {
constexpr int BM = 256, BK = 64, HALF = 128, HTB = HALF * BK * 2, STAGE_BYTES = 8 * HTB, NXCD = 8, WGM = 8;
__host__ __device__ __forceinline__ int lds_byte(int r, int c) { const int st = (r >> 4) * 2 + (c >> 5), rr = r & 15, cc = c & 31, ob = rr * 64 + cc * 2; return st * 1024 + (ob ^ (((ob >> 9) & 1) << 5)); }
__host__ __device__ __forceinline__ void stage_rc(int b, int& R, int& C) { const int st = b / 1024, sb = b % 1024, swz = sb ^ (((sb >> 9) & 1) << 5); R = (st >> 1) * 16 + swz / 64; C = (st & 1) * 32 + (swz % 64) / 2; }
__host__ __device__ __forceinline__ int perm32(int rho) { const int n = rho >> 4, i = rho & 15; return 8 * (i >> 2) + 4 * n + (i & 3); }

struct Unit { const char* A; const char* B; const int* ridx; const float* wl; int nrows; int r0, c0, aux; };

template <class Epi, class Sched, bool GATHER>
__device__ __forceinline__ void gemm_phase(LAS unsigned char* lds, const int tid_in, const int K, const unsigned lda, const unsigned ldb, const Sched& S, const Epi& E) {
    const int tid = tid_in, wid = __builtin_amdgcn_readfirstlane(tid >> 6), lane = tid & 63, wr = wid >> 2, wc = wid & 3, fr = lane & 15, fq = lane >> 4;
    const int nt = K / BK;
    int sR[2], sC[2];
    unsigned voffA[2], voffB[2], cvA[2][2], nvA[2][2];
#pragma unroll
    for (int i = 0; i < 2; ++i) { int R, C; stage_rc(tid * 16 + i * 8192, R, C); sR[i] = R; sC[i] = C; const int Rb = Epi::PERM ? ((R & ~31) + perm32(R & 31)) : R;
        voffA[i] = (unsigned)R * lda + (unsigned)C * 2u; voffB[i] = (unsigned)Rb * ldb + (unsigned)C * 2u;
#pragma unroll
        for (int h = 0; h < 2; ++h) { cvA[h][i] = 0u; nvA[h][i] = 0u; } }
    const size_t kstep = (size_t)(BK * 2);
    const size_t hstepA = (size_t)HALF * lda, hstepB = (size_t)HALF * ldb;
    const unsigned ldsw = (unsigned)wid * 1024u;
    const int aoff = lds_byte(wr * 64 + fr, fq * 8), boff = lds_byte(wc * 32 + fr, fq * 8);
#define PG8_SA(b, h) (((b) * 2 + (h)) * HTB)
#define PG8_SB(b, h) ((4 + (b) * 2 + (h)) * HTB)
#define PG8_STGX(bufoff, gbase, o0, o1, AUX) do { \
        __builtin_amdgcn_global_load_lds((const unsigned*)((const char*)(gbase) + (o0)), (LAS unsigned*)(lds + (bufoff) + ldsw), 16, 0, AUX); \
        __builtin_amdgcn_global_load_lds((const unsigned*)((const char*)(gbase) + (o1)), (LAS unsigned*)(lds + (bufoff) + ldsw + 8192), 16, 0, AUX); } while (0)
#define PG8_STG(bufoff, gbase, o0, o1) PG8_STGX(bufoff, gbase, o0, o1, 0)
#define PG8_STGA(bufoff, gbase, h, NXT) do { if (GATHER) { const unsigned o0_ = (NXT) ? nvA[h][0] : cvA[h][0], o1_ = (NXT) ? nvA[h][1] : cvA[h][1]; PG8_STG(bufoff, gbase, o0_, o1_); } \
        else if (Sched::HAS_WAIT) { PG8_STGX(bufoff, (gbase) + (h) * hstepA, voffA[0], voffA[1], A_AUX_WAIT); } \
        else { PG8_STG(bufoff, (gbase) + (h) * hstepA, voffA[0], voffA[1]); } } while (0)
#define PG8_STGB(bufoff, gbase, h) PG8_STG(bufoff, (gbase) + (h) * hstepB, voffB[0], voffB[1])
#define PG8_LDA(dst, b, h) do { _Pragma("unroll") for (int m = 0; m < 4; ++m) _Pragma("unroll") for (int k = 0; k < 2; ++k) dst[m][k] = *(const LAS bf16x8*)(lds + PG8_SA(b, h) + aoff + m * 2048 + k * 1024); } while (0)
#define PG8_LDB(dst, b, h) do { _Pragma("unroll") for (int n = 0; n < 2; ++n) _Pragma("unroll") for (int k = 0; k < 2; ++k) dst[n][k] = *(const LAS bf16x8*)(lds + PG8_SB(b, h) + boff + n * 2048 + k * 1024); } while (0)
#define PG8_MMA(ai, bj, At, Bt) do { __builtin_amdgcn_s_setprio(1); _Pragma("unroll") for (int m = 0; m < 4; ++m) _Pragma("unroll") for (int n = 0; n < 2; ++n) _Pragma("unroll") for (int k = 0; k < 2; ++k) \
        acc[ai][bj][m][n] = __builtin_amdgcn_mfma_f32_16x16x32_bf16(Bt[n][k], At[m][k], acc[ai][bj][m][n], 0, 0, 0); __builtin_amdgcn_s_setprio(0); } while (0)
#define PG8_WAIT_V(n) asm volatile("s_waitcnt vmcnt(" #n ")" ::: "memory")
#define PG8_WAIT_L(n) asm volatile("s_waitcnt lgkmcnt(" #n ")" ::: "memory")
#define PG8_BAR __builtin_amdgcn_s_barrier()
#define PG8_SCHED __builtin_amdgcn_sched_barrier(0)
#define PG8_GOFF(u, dst) do { if (GATHER) { _Pragma("unroll") for (int i = 0; i < 2; ++i) _Pragma("unroll") for (int h = 0; h < 2; ++h) { const int x = sR[i] + 128 * h; \
        const int tok = (x < (u).nrows) ? ((u).ridx[x] >> 1) : 0; dst[h][i] = (unsigned)tok * lda + (unsigned)sC[i] * 2u; } } } while (0)
    Unit cur, nxt; int ui = 0;
    if (!S.next(0, cur)) return;
    if constexpr (Sched::HAS_WAIT) S.wait(cur);
    f32x4 acc[2][2][4][2];
#pragma unroll
    for (int a = 0; a < 2; ++a)
#pragma unroll
        for (int b = 0; b < 2; ++b)
#pragma unroll
            for (int m = 0; m < 4; ++m)
#pragma unroll
                for (int n = 0; n < 2; ++n) acc[a][b][m][n] = (f32x4){0.f, 0.f, 0.f, 0.f};
    bf16x8 At[4][2], B0[2][2], B1[2][2];
    const char* cA = cur.A; const char* cB = cur.B;
    PG8_GOFF(cur, cvA);
    PG8_STGB(PG8_SB(0, 0), cB, 0); PG8_STGA(PG8_SA(0, 0), cA, 0, false); PG8_STGB(PG8_SB(0, 1), cB, 1); PG8_STGA(PG8_SA(0, 1), cA, 1, false);
    if (wr == 1) PG8_BAR;
    PG8_WAIT_V(4); PG8_BAR;
    PG8_STGB(PG8_SB(1, 0), cB + kstep, 0); PG8_STGA(PG8_SA(1, 0), cA + kstep, 0, false); PG8_STGB(PG8_SB(1, 1), cB + kstep, 1);
    PG8_WAIT_V(6); PG8_BAR;
    for (;;) {
        const bool has_next = S.next(ui + 1, nxt);
        const char* nA = has_next ? nxt.A : cA; const char* nB = has_next ? nxt.B : cB;
        if (GATHER) { if (has_next) { PG8_GOFF(nxt, nvA); } else {
#pragma unroll
            for (int i = 0; i < 2; ++i)
#pragma unroll
                for (int h = 0; h < 2; ++h) nvA[h][i] = cvA[h][i]; } }
        for (int t = 0; t < nt; t += 2) {
            const bool last = (t == nt - 2);
            if constexpr (Sched::HAS_WAIT) { if (last && has_next) S.wait(nxt); }
            const char* a1 = cA + (size_t)(t + 1) * kstep;
            const char* a2 = last ? nA : cA + (size_t)(t + 2) * kstep; const char* b2 = last ? nB : cB + (size_t)(t + 2) * kstep;
            const char* a3 = a2 + kstep; const char* b3 = b2 + kstep;
            PG8_LDB(B0, 0, 0); PG8_SCHED; PG8_LDA(At, 0, 0); PG8_STGA(PG8_SA(1, 1), a1, 1, false);
            PG8_WAIT_L(8); PG8_BAR; PG8_WAIT_L(0); PG8_MMA(0, 0, At, B0); PG8_BAR; PG8_SCHED;
            PG8_LDB(B1, 0, 1); PG8_STGB(PG8_SB(0, 0), b2, 0);
            PG8_BAR; PG8_WAIT_L(0); PG8_MMA(0, 1, At, B1); PG8_BAR;
            PG8_LDA(At, 0, 1); PG8_STGA(PG8_SA(0, 0), a2, 0, last);
            PG8_BAR; PG8_WAIT_L(0); PG8_MMA(1, 0, At, B0); PG8_BAR; PG8_SCHED;
            PG8_STGB(PG8_SB(0, 1), b2, 1);
            PG8_WAIT_V(6); PG8_BAR; PG8_MMA(1, 1, At, B1); PG8_BAR;
            PG8_LDB(B0, 1, 0); PG8_SCHED; PG8_LDA(At, 1, 0); PG8_STGA(PG8_SA(0, 1), a2, 1, last);
            PG8_WAIT_L(8); PG8_BAR; PG8_WAIT_L(0); PG8_MMA(0, 0, At, B0); PG8_BAR; PG8_SCHED;
            PG8_LDB(B1, 1, 1); PG8_STGB(PG8_SB(1, 0), b3, 0);
            PG8_BAR; PG8_WAIT_L(0); PG8_MMA(0, 1, At, B1); PG8_BAR;
            PG8_LDA(At, 1, 1); PG8_STGA(PG8_SA(1, 0), a3, 0, last);
            PG8_BAR; PG8_WAIT_L(0); PG8_MMA(1, 0, At, B0); PG8_BAR; PG8_SCHED;
            PG8_STGB(PG8_SB(1, 1), b3, 1);
            PG8_WAIT_V(6); PG8_BAR; PG8_MMA(1, 1, At, B1); PG8_BAR;
        }
        E(acc, cur, wr, wc, fr, fq);
        if (!has_next) break;
#pragma unroll
        for (int a = 0; a < 2; ++a)
#pragma unroll
            for (int b = 0; b < 2; ++b)
#pragma unroll
                for (int m = 0; m < 4; ++m)
#pragma unroll
                    for (int n = 0; n < 2; ++n) acc[a][b][m][n] = (f32x4){0.f, 0.f, 0.f, 0.f};
        cur = nxt; cA = nA; cB = nB; ++ui;
        if (GATHER) {
#pragma unroll
            for (int i = 0; i < 2; ++i)
#pragma unroll
                for (int h = 0; h < 2; ++h) cvA[h][i] = nvA[h][i]; }
    }
    PG8_WAIT_V(0);
    if (wr == 0) PG8_BAR;
    PG8_BAR;
#undef PG8_SA
#undef PG8_SB
#undef PG8_STG
#undef PG8_STGX
#undef PG8_STGA
#undef PG8_STGB
#undef PG8_LDA
#undef PG8_LDB
#undef PG8_MMA
#undef PG8_WAIT_V
#undef PG8_WAIT_L
#undef PG8_BAR
#undef PG8_SCHED
#undef PG8_GOFF
}

struct DenseOrder {
    static constexpr bool HAS_WAIT = false;
    const char* A; const char* B; unsigned lda, ldb; int nM, nN, nwg, G, c;
    __device__ void init(const void* A_, const void* B_, unsigned lda_, unsigned ldb_, int M, int N, int G_, int c_) { A = (const char*)A_; B = (const char*)B_; lda = lda_; ldb = ldb_; nM = M / BM; nN = N / BM; nwg = nM * nN; G = G_; c = c_; }
    __device__ bool next(int i, Unit& u) const {
        const long L = (long)i * G + c; if (L >= nwg) return false;
        int wgid = (int)L; { const int q = nwg / NXCD, r = nwg % NXCD, xcd = wgid % NXCD, off = wgid / NXCD; wgid = (xcd < r ? xcd * (q + 1) : r * (q + 1) + (xcd - r) * q) + off; }
        const int nig = WGM * nN, gid = wgid / nig, fm = gid * WGM, gsz = (nM - fm) < WGM ? (nM - fm) : WGM;
        const int pm = fm + ((wgid % nig) % gsz), pn = (wgid % nig) / gsz;
        u.A = A + (size_t)pm * BM * lda; u.B = B + (size_t)pn * BM * ldb; u.ridx = nullptr; u.wl = nullptr; u.nrows = BM; u.r0 = pm * BM; u.c0 = pn * BM; u.aux = 0; return true;
    }
};
}
struct Args { const float* in[36]; float* out; unsigned char* ws; int ph_lo, ph_hi, flags, pad; };
struct Ctx {
    const float* const* in; float* out; unsigned char* ws; unsigned char* ws0;
    LAS unsigned char* lds; unsigned char* ldsg;
    int tid, lane, wave, G, bid, vcu, flags;
};
__device__ __forceinline__ void fresh(Ctx& C) {
    int t_ = threadIdx.x; asm volatile("" : "+v"(t_)); C.tid = t_; C.lane = t_ & 63; C.wave = __builtin_amdgcn_readfirstlane(t_ >> 6);
    int b_ = blockIdx.x; asm volatile("" : "+s"(b_)); C.bid = b_; int g_ = gridDim.x; asm volatile("" : "+s"(g_)); C.G = g_;
    C.vcu = (g_ % 8 == 0) ? (b_ % 8) * (g_ / 8) + b_ / 8 : b_;
    unsigned char* w_ = C.ws0; asm volatile("" : "+s"(w_)); C.ws = w_;
}
enum { IN_X = 0, IN_C, IN_ADAW, IN_ADAB, IN_N1G, IN_N2G, IN_WIN, IN_QNG, IN_KNG, IN_LAM, IN_SUBLN, IN_MU, IN_WUP, IN_W0, IN_AUP, IN_A0, IN_GUP, IN_KK, IN_KA, IN_RK, IN_LNG, IN_LNB,
       IN_GAUP, IN_GAB, IN_GNG, IN_PA, IN_PR, IN_PG, IN_WOUT, IN_RGW, IN_RGB, IN_REW, IN_REB, IN_EG, IN_EU, IN_ED };

__device__ __forceinline__ void transpose_item(const float* __restrict__ src, int ldn, int ns0, int nvalid, bf16_t* dst, int ldk, int nd0, int k0, LAS float* scr, int lane) {
    const int kq = lane >> 3, n4 = (lane & 7) * 4;
    f32x4 v[8];
#pragma unroll
    for (int i = 0; i < 8; ++i) { const int kk = 8 * i + kq; v[i] = (n4 < nvalid) ? *(const f32x4*)(src + (size_t)kk * ldn + ns0 + n4) : (f32x4){0.f, 0.f, 0.f, 0.f}; }
#pragma unroll
    for (int i = 0; i < 8; ++i) { const int kk = 8 * i + kq; LAS float* d = scr + kk * 33 + n4; d[0] = v[i][0]; d[1] = v[i][1]; d[2] = v[i][2]; d[3] = v[i][3]; }
    asm volatile("s_waitcnt lgkmcnt(0)" ::: "memory");
    const int c = lane & 7;
#pragma unroll
    for (int j = 0; j < 4; ++j) { const int n = (lane >> 3) + 8 * j; const LAS float* s = scr + (8 * c) * 33 + n;
        u32x4 o; o.x = pk2(s[0 * 33], s[1 * 33]); o.y = pk2(s[2 * 33], s[3 * 33]); o.z = pk2(s[4 * 33], s[5 * 33]); o.w = pk2(s[6 * 33], s[7 * 33]);
        *(u32x4*)(dst + (size_t)(nd0 + n) * ldk + k0 + 8 * c) = o; }
    asm volatile("s_waitcnt lgkmcnt(0)" ::: "memory");
}

__device__ __forceinline__ void phase_prologue(const Ctx& C) {
    float* cact = (float*)C.ldsg;
    float* red = (float*)(C.ldsg + 32768);
    if (C.bid < 192) {
        for (int i = C.tid; i < 8192; i += NTHR) { const float v = C.in[IN_C][i]; cact[i] = siluf_(v); }
        __syncthreads();
        for (int it = C.bid; it < 192; it += C.G) {
            const int l = it / 96, jb = it % 96, jj = C.tid & 63, ks = C.tid >> 6;
            const float* W = C.in[IN_ADAW] + (size_t)l * 1024 * 6144 + jb * 64 + jj;
            float a[8];
#pragma unroll
            for (int b = 0; b < 8; ++b) a[b] = 0.f;
            for (int k = ks * 128; k < ks * 128 + 128; ++k) { const float w = W[(size_t)k * 6144];
#pragma unroll
                for (int b = 0; b < 8; ++b) a[b] += cact[b * 1024 + k] * w; }
#pragma unroll
            for (int b = 0; b < 8; ++b) red[(ks * 8 + b) * 64 + jj] = a[b];
            __syncthreads();
            { const int b = C.tid >> 6; float s = 0.f;
#pragma unroll
              for (int k2 = 0; k2 < 8; ++k2) s += red[(k2 * 8 + b) * 64 + jj];
              ((float*)(C.ws + WS_MOD))[((size_t)l * 8 + b) * 6144 + jb * 64 + jj] = s + C.in[IN_ADAB][l * 6144 + jb * 64 + jj]; }
            __syncthreads();
        }
    }
    __syncthreads();
    LAS float* scr = (LAS float*)(C.lds + 65536 + C.wave * 8448);
    const int gw = C.bid * NWAVES + C.wave, NGW = C.G * NWAVES;
    constexpr int I_WIN = 2 * 16 * 256, I_PROJ = 6 * 8 * 32, I_WOUT = 2 * 16 * 32, I_LW = 2 * 4 * 16;
    for (int it = gw; it < I_WIN + I_PROJ + I_WOUT + I_LW; it += NGW) {
        int r = it;
        if (r >= I_WIN + I_PROJ + I_WOUT) { r -= I_WIN + I_PROJ + I_WOUT; const int l = r / 64, q = r % 64, kb4 = q / 16, nb = q % 16;
            const float* src = (kb4 == 0) ? C.in[IN_WUP] + (size_t)l * 64 * 512 : (kb4 == 1) ? C.in[IN_AUP] + (size_t)l * 64 * 512 : C.in[IN_GUP] + (size_t)l * 128 * 512 + (size_t)(kb4 - 2) * 64 * 512;
            transpose_item(src, 512, 32 * nb, 32, ((bf16_t*)(C.ws + WS_LW)) + (size_t)l * 512 * 256, 256, 32 * nb, 64 * kb4, scr, C.lane); continue; }
        if (r < I_WIN) { const int l = r / 4096, q = r % 4096, kb = q / 256, nb = q % 256, n0 = 32 * nb;
            int ns0 = 0, nv = 32;
            if (n0 < 4352) ns0 = n0; else if (n0 < 7936) ns0 = n0 + 16; else if (n0 == 7936) { ns0 = 4352; nv = 16; } else nv = 0;
            transpose_item(C.in[IN_WIN] + (size_t)l * 1024 * NIN_ + (size_t)(64 * kb) * NIN_, NIN_, ns0, nv, ((bf16_t*)(C.ws + WS_WIN)) + (size_t)l * NP_ * 1024, 1024, n0, 64 * kb, scr, C.lane); continue; }
        r -= I_WIN;
        if (r < I_PROJ) { const int lb = r / 256, q = r % 256, kb = q / 32, nb = q % 32, l = lb / 3, br = lb % 3;
            const float* src = C.in[IN_PA + br] + (size_t)l * 512 * 1024 + (size_t)(64 * kb) * 1024;
            transpose_item(src, 1024, 32 * nb, 32, ((bf16_t*)(C.ws + WS_WPROJ)) + (size_t)(l * 3 + br) * 1024 * 512, 512, 32 * nb, 64 * kb, scr, C.lane); continue; }
        r -= I_PROJ;
        { const int l = r / 512, q = r % 512, kb = q / 32, nb = q % 32;
          transpose_item(C.in[IN_WOUT] + (size_t)l * 1024 * 1024 + (size_t)(64 * kb) * 1024, 1024, 32 * nb, 32, ((bf16_t*)(C.ws + WS_WOUT)) + (size_t)l * 1024 * 1024, 1024, 32 * nb, 64 * kb, scr, C.lane); }
    }
}

__device__ __forceinline__ void phase_rows(const Ctx& C, int l, int mode) {
    const int gw = C.bid * NWAVES + C.wave, NGW = C.G * NWAVES;
    const float* xin = (mode & 1) ? C.out : C.in[IN_X];
    for (int t = gw; t < T_; t += NGW) {
        const int b = t >> 11;
        f32x4 v[4];
#pragma unroll
        for (int j = 0; j < 4; ++j) v[j] = *(const f32x4*)(xin + (size_t)t * 1024 + 4 * C.lane + 256 * j);
        if (mode & 1) {
            const float* gt2 = ((float*)(C.ws + WS_MOD)) + ((size_t)(l - 1) * 8 + b) * 6144 + 5120;
#pragma unroll
            for (int j = 0; j < 4; ++j) { const int col = 4 * C.lane + 256 * j;
                const u32x2 y0 = *(const u32x2*)(((bf16_t*)(C.ws + WS_YS)) + (size_t)(2 * t) * 1024 + col), y1 = *(const u32x2*)(((bf16_t*)(C.ws + WS_YS)) + (size_t)(2 * t + 1) * 1024 + col);
                const f32x4 g = *(const f32x4*)(gt2 + col);
                v[j][0] += g[0] * (lo16(y0.x) + lo16(y1.x)); v[j][1] += g[1] * (hi16(y0.x) + hi16(y1.x));
                v[j][2] += g[2] * (lo16(y0.y) + lo16(y1.y)); v[j][3] += g[3] * (hi16(y0.y) + hi16(y1.y));
                *(f32x4*)(C.out + (size_t)t * 1024 + col) = v[j]; }
        }
        if (mode & 2) {
            float ss = 0.f;
#pragma unroll
            for (int j = 0; j < 4; ++j) ss += v[j][0] * v[j][0] + v[j][1] * v[j][1] + v[j][2] * v[j][2] + v[j][3] * v[j][3];
            ss = wave_sum(ss);
            const float rstd = rsqrtf(ss * (1.f / 1024.f) + 1e-6f);
            const float* md = ((float*)(C.ws + WS_MOD)) + ((size_t)l * 8 + b) * 6144;
#pragma unroll
            for (int j = 0; j < 4; ++j) { const int col = 4 * C.lane + 256 * j;
                const f32x4 g = *(const f32x4*)(C.in[IN_N1G] + l * 1024 + col), sh = *(const f32x4*)(md + col), sc = *(const f32x4*)(md + 1024 + col);
                float o[4];
#pragma unroll
                for (int e = 0; e < 4; ++e) o[e] = v[j][e] * rstd * g[e] * (1.f + sc[e]) + sh[e];
                u32x2 w; w.x = pk2(o[0], o[1]); w.y = pk2(o[2], o[3]);
                *(u32x2*)(((bf16_t*)(C.ws + WS_H)) + (size_t)t * 1024 + col) = w; }
        }
    }
}

struct EpiP {
    static constexpr bool PERM = true; unsigned char* ws;
    __device__ __forceinline__ void operator()(const f32x4 (&acc)[2][2][4][2], const pg8::Unit& u, int wr, int wc, int fr, int fq) const {
        const int pn = u.c0 >> 8;
        size_t off; int mode = 0, ld = 0, hdsh = 6, nh = 8, cs0;
        if (pn < 2)        { off = WS_QH; mode = 1; hdsh = 6; nh = 8; cs0 = u.c0; }
        else if (pn < 4)   { off = WS_KH; mode = 1; hdsh = 6; nh = 8; cs0 = u.c0 - 512; }
        else if (pn < 6)   { off = WS_AV; ld = 512; cs0 = u.c0 - 1024; }
        else if (pn < 13)  { off = WS_RWS; ld = 1792; cs0 = u.c0 - 1536; }
        else if (pn < 14)  { off = WS_GQ; mode = 1; hdsh = 6; nh = 4; cs0 = 0; }
        else if (pn < 15)  { off = WS_GK; mode = 1; hdsh = 6; nh = 4; cs0 = 0; }
        else if (pn < 17)  { off = WS_GV; mode = 1; hdsh = 7; nh = 4; cs0 = u.c0 - 3840; }
        else if (pn < 19)  { off = WS_GG; mode = 1; hdsh = 7; nh = 4; cs0 = u.c0 - 4352; }
        else if (pn < 31)  { off = WS_GATES; ld = 3072; cs0 = u.c0 - 4864; }
        else               { off = WS_GAD; mode = 2; ld = 16; cs0 = 0; }
        bf16_t* base = (bf16_t*)(ws + off);
#pragma unroll
        for (int ai = 0; ai < 2; ++ai)
#pragma unroll
            for (int m = 0; m < 4; ++m) { const int row = u.r0 + 128 * ai + 64 * wr + 16 * m + fr; const int b = row >> 11, s = row & 2047;
#pragma unroll
                for (int bj = 0; bj < 2; ++bj) { const f32x4 v0 = acc[ai][bj][m][0], v1 = acc[ai][bj][m][1];
                    u32x4 w; w.x = pk2(v0[0], v0[1]); w.y = pk2(v0[2], v0[3]); w.z = pk2(v1[0], v1[1]); w.w = pk2(v1[2], v1[3]);
                    const int cs = cs0 + 128 * bj + 32 * wc + 8 * fq;
                    if (mode == 1) { const int hidx = cs >> hdsh, din = cs & ((1 << hdsh) - 1); *(u32x4*)(base + ((((size_t)b * nh + hidx) * S_ + s) << hdsh) + din) = w; }
                    else if (mode == 0) { *(u32x4*)(base + (size_t)row * ld + cs) = w; }
                    else { if (cs < 16) *(u32x4*)(base + (size_t)row * 16 + cs) = w; } } }
    }
};
struct EpiMerge {
    static constexpr bool PERM = true; const bf16_t* GATES; bf16_t* MG;
    __device__ __forceinline__ void operator()(const f32x4 (&acc)[2][2][4][2], const pg8::Unit& u, int wr, int wc, int fr, int fq) const {
#pragma unroll
        for (int ai = 0; ai < 2; ++ai)
#pragma unroll
            for (int m = 0; m < 4; ++m) { const size_t row = (size_t)(u.r0 + 128 * ai + 64 * wr + 16 * m + fr); const int col = u.c0 + 32 * wc + 8 * fq;
#pragma unroll
                for (int bj = 0; bj < 2; ++bj) { const f32x4 v0 = acc[ai][bj][m][0], v1 = acc[ai][bj][m][1];
                    const u32x4 g = *(const u32x4*)(GATES + row * 3072 + u.aux * 1024 + col + 128 * bj);
                    float o[8];
                    o[0] = sigmoidf_(lo16(g.x)) * v0[0]; o[1] = sigmoidf_(hi16(g.x)) * v0[1]; o[2] = sigmoidf_(lo16(g.y)) * v0[2]; o[3] = sigmoidf_(hi16(g.y)) * v0[3];
                    o[4] = sigmoidf_(lo16(g.z)) * v1[0]; o[5] = sigmoidf_(hi16(g.z)) * v1[1]; o[6] = sigmoidf_(lo16(g.w)) * v1[2]; o[7] = sigmoidf_(hi16(g.w)) * v1[3];
                    bf16_t* mp = MG + row * 1024 + col + 128 * bj;
                    if (u.aux > 0) { const u32x4 p = *(const u32x4*)mp;
                        o[0] += lo16(p.x); o[1] += hi16(p.x); o[2] += lo16(p.y); o[3] += hi16(p.y); o[4] += lo16(p.z); o[5] += hi16(p.z); o[6] += lo16(p.w); o[7] += hi16(p.w); }
                    u32x4 w; w.x = pk2(o[0], o[1]); w.y = pk2(o[2], o[3]); w.z = pk2(o[4], o[5]); w.w = pk2(o[6], o[7]);
                    *(u32x4*)mp = w; } }
    }
};
struct EpiOut {
    static constexpr bool PERM = false; const float* xin; float* out; const float* gt;
    __device__ __forceinline__ void operator()(const f32x4 (&acc)[2][2][4][2], const pg8::Unit& u, int wr, int wc, int fr, int fq) const {
#pragma unroll
        for (int ai = 0; ai < 2; ++ai)
#pragma unroll
            for (int m = 0; m < 4; ++m) { const int row = u.r0 + 128 * ai + 64 * wr + 16 * m + fr; const int b = row >> 11;
#pragma unroll
                for (int bj = 0; bj < 2; ++bj)
#pragma unroll
                    for (int n = 0; n < 2; ++n) { const int col = u.c0 + 128 * bj + 32 * wc + 16 * n + 4 * fq;
                        const f32x4 x = *(const f32x4*)(xin + (size_t)row * 1024 + col), g = *(const f32x4*)(gt + (size_t)b * 6144 + col);
                        *(f32x4*)(out + (size_t)row * 1024 + col) = x + g * acc[ai][bj][m][n]; } }
    }
};
#ifndef HID_WT
#define HID_WT 1
#endif
struct EpiHid {
    static constexpr bool PERM = true; bf16_t* HID; unsigned* done;
    __device__ __forceinline__ void operator()(const f32x4 (&acc)[2][2][4][2], const pg8::Unit& u, int wr, int wc, int fr, int fq) const {
#pragma unroll
        for (int ai = 0; ai < 2; ++ai)
#pragma unroll
            for (int m = 0; m < 4; ++m) { bf16_t* rowp = HID + (size_t)(u.r0 + 128 * ai + 64 * wr + 16 * m + fr) * 512 + u.c0 + 32 * wc + 8 * fq;
                float o[8];
#pragma unroll
                for (int n = 0; n < 2; ++n)
#pragma unroll
                    for (int j = 0; j < 4; ++j) o[4 * n + j] = siluf_(acc[ai][0][m][n][j]) * acc[ai][1][m][n][j];
                u32x4 w; w.x = pk2(o[0], o[1]); w.y = pk2(o[2], o[3]); w.z = pk2(o[4], o[5]); w.w = pk2(o[6], o[7]);
#if HID_WT
                asm volatile("global_store_dwordx4 %0, %1, off sc1\n\ts_nop 2" :: "v"(rowp), "v"(w) : "memory"); }
#else
                *(u32x4*)rowp = w; }
        __builtin_amdgcn_fence(__ATOMIC_RELEASE, "agent");
#endif
        asm volatile("s_waitcnt vmcnt(0)" ::: "memory");
        if (fr == 0 && fq == 0) __hip_atomic_store(done + 32 * (u.r0 >> 8) + 8 * (u.c0 >> 7) + 4 * wr + wc, 1u, __ATOMIC_RELAXED, __HIP_MEMORY_SCOPE_AGENT);
    }
};
struct EpiDown {
    static constexpr bool PERM = true; bf16_t* YS;
    __device__ __forceinline__ void operator()(const f32x4 (&acc)[2][2][4][2], const pg8::Unit& u, int wr, int wc, int fr, int fq) const {
#pragma unroll
        for (int ai = 0; ai < 2; ++ai)
#pragma unroll
            for (int m = 0; m < 4; ++m) { const int rloc = 128 * ai + 64 * wr + 16 * m + fr;
                if (rloc < u.nrows) { const int slot = u.ridx[rloc]; const float wgt = u.wl[rloc];
                    bf16_t* rowp = YS + (size_t)slot * 1024 + u.c0 + 32 * wc + 8 * fq;
#pragma unroll
                    for (int bj = 0; bj < 2; ++bj) { const f32x4 v0 = acc[ai][bj][m][0] * wgt, v1 = acc[ai][bj][m][1] * wgt;
                        u32x4 w; w.x = pk2(v0[0], v0[1]); w.y = pk2(v0[2], v0[3]); w.z = pk2(v1[0], v1[1]); w.w = pk2(v1[2], v1[3]);
                        *(u32x4*)(rowp + 128 * bj) = w; } } }
    }
};
struct WinOrder {
    static constexpr bool HAS_WAIT = false;
    const char* A; const char* B; int G, c;
    __device__ bool next(int i, pg8::Unit& u) const {
        constexpr int nM = 64, nN = 24, nwg = nM * nN;
        const long L = (long)i * G + c; if (L >= nwg) return false;
        int wgid = (int)L; { const int q = nwg / 8, r = nwg % 8, xcd = wgid % 8, off = wgid / 8; wgid = (xcd < r ? xcd * (q + 1) : r * (q + 1) + (xcd - r) * q) + off; }
        const int nig = 8 * nN, gid = wgid / nig, fm = gid * 8;
        const int pm = fm + ((wgid % nig) % 8); int pn = (wgid % nig) / 8; pn = (pn < 23) ? pn : 31;
        u.A = A + (size_t)pm * 256 * 2048; u.B = B + (size_t)pn * 256 * 2048; u.ridx = nullptr; u.wl = nullptr; u.nrows = 256; u.r0 = pm * 256; u.c0 = pn * 256; u.aux = 0; return true;
    }
};
struct GateOrder {
    static constexpr bool HAS_WAIT = false;
    const char* A; const char* B; int q;
    __device__ bool next(int i, pg8::Unit& u) const {
        if (i >= 4) return false;
        const int pm = q >> 1, pn = 23 + 4 * (q & 1) + i;
        u.A = A + (size_t)pm * 256 * 2048; u.B = B + (size_t)pn * 256 * 2048; u.ridx = nullptr; u.wl = nullptr; u.nrows = 256; u.r0 = pm * 256; u.c0 = pn * 256; u.aux = 0; return true;
    }
};
struct MergeOrder {
    static constexpr bool HAS_WAIT = false;
    const bf16_t *O0, *O1, *O2; const bf16_t* W; int G, c;
    __device__ bool next(int i, pg8::Unit& u) const {
        const int br = i % 3, tile = c + (i / 3) * G; if (tile >= 256) return false;
        const int pm = tile >> 2, pn = tile & 3;
        const bf16_t* Ob = (br == 0) ? O0 : ((br == 1) ? O1 : O2); u.A = (const char*)(Ob + (size_t)pm * 256 * 512); u.B = (const char*)(W + (size_t)br * 1024 * 512 + (size_t)pn * 256 * 512);
        u.ridx = nullptr; u.wl = nullptr; u.nrows = 256; u.r0 = pm * 256; u.c0 = pn * 256; u.aux = br; return true;
    }
};
struct MoeOrder {
    static constexpr bool HAS_WAIT = true;
    const LAS int* tab; const char* A; const char* B; const int* LIST; const float* WL; int G, c, down; const unsigned* done;
    __device__ __forceinline__ void wait(const pg8::Unit& u) const {
        if (down) { const int ln = (int)__builtin_amdgcn_mbcnt_hi(~0u, __builtin_amdgcn_mbcnt_lo(~0u, 0u)) & 31;
            const unsigned* p = done + 32 * (u.r0 >> 8) + ln; int spins = 0;
            while (!__all(__hip_atomic_load(p, __ATOMIC_RELAXED, __HIP_MEMORY_SCOPE_AGENT) == 1u) && ++spins < (1 << 22)) __builtin_amdgcn_s_sleep(2);
            if (A_AUX_WAIT == 0) __builtin_amdgcn_fence(__ATOMIC_ACQUIRE, "agent");
            else asm volatile("s_waitcnt vmcnt(0)" ::: "memory"); }
    }
    __device__ bool next(int i, pg8::Unit& u) const {
        const int nU = 4 * tab[32];
        int L = i * G + c;
        if (down) { int r = nU - 2 * G; r = r < 0 ? 0 : (r > G ? G : r); const int nW = G - r;
            if (c >= r) L = (i < 3) ? i * nW + (c - r) : 3 * nW + (i - 3) * G + c; else L = 3 * nW + i * G + c; }
        const int R = L >> 2, ct = L & 3; if (L >= nU) return false;
        int e = 0;
#pragma unroll 1
        while (tab[e + 1] <= R) ++e;
        const int rt = R - tab[e], n = tab[33 + e] - 256 * rt;
        u.nrows = n < 256 ? n : 256; u.ridx = LIST + (size_t)e * ECAP + 256 * rt; u.wl = WL + (size_t)e * ECAP + 256 * rt; u.aux = e;
        if (!down) { u.A = A; u.B = B + ((size_t)e * 1024 + 256 * ct) * 2048; u.r0 = 256 * R; u.c0 = 128 * ct; }
        else       { u.A = A + (size_t)256 * R * 1024; u.B = B + ((size_t)e * 1024 + 256 * ct) * 1024; u.r0 = 256 * R; u.c0 = 256 * ct; }
        return true;
    }
};
__device__ __forceinline__ void moe_build_table(const Ctx& C, int l) {
    LAS int* tab = (LAS int*)(C.lds + LDS_SCHED);
    if (C.tid == 0) { int acc = 0;
        for (int e = 0; e < 32; ++e) { const int n = (int)__hip_atomic_load(((unsigned*)(C.ws + WS_CTL)) + CW_CNT + l * 2048 + 64 * e, __ATOMIC_RELAXED, __HIP_MEMORY_SCOPE_AGENT); tab[e] = acc; tab[33 + e] = n; acc += (n + 255) >> 8; }
        tab[32] = acc; }
    __syncthreads();
}
__device__ __forceinline__ float mixv(float x, float prev, float mu) { return x + (prev - x) * mu; }
__device__ __forceinline__ void phase_prep(const Ctx& C, int l) {
    bf16_t* xs = (bf16_t*)C.ldsg;
    bf16_t* vts = (bf16_t*)(C.ldsg + 32768);
    float* gs = (float*)(C.ldsg + 16896);
    constexpr int PS_STG = 20480, PS_ARR = 32 * 144, PS_SLOT = 6 * PS_ARR, PS_RED = 131072;
    const int tid = C.tid, lane = C.lane;
    const float* mu = C.in[IN_MU] + l * 1792;
    for (int item = C.bid; item < T_ / 32; item += C.G) {
        const int t0 = item * 32, b = t0 >> 11, s0 = t0 & 2047;
        const bf16_t* RWt = ((const bf16_t*)(C.ws + WS_RWS)) + (size_t)t0 * 1792;
        if (!(C.flags & 16)) { const int g = tid >> 5, tok = tid & 31;
          bf16_t* p = ((bf16_t*)(C.ws + (g < 8 ? WS_QH : WS_KH))) + (((size_t)b * 8 + (g & 7)) * S_ + s0 + tok) * 64; u32x4 raw[8]; float ss = 0.f;
#pragma unroll
          for (int i = 0; i < 8; ++i) { raw[i] = *(const u32x4*)(p + 8 * i);
#pragma unroll
              for (int e = 0; e < 4; ++e) { const float a = lo16(raw[i][e]), c2 = hi16(raw[i][e]); ss += a * a + c2 * c2; } }
          const float rstd = rsqrtf(ss * (1.f / 64.f) + 1e-6f) * ((g < 8) ? 0.125f : 1.0f);
          const float* gn = (g < 8) ? C.in[IN_QNG] + l * 64 : C.in[IN_KNG] + l * 64;
#pragma unroll
          for (int i = 0; i < 8; ++i) { u32x4 w;
#pragma unroll
              for (int e = 0; e < 4; ++e) w[e] = pk2(lo16(raw[i][e]) * rstd * gn[8 * i + 2 * e], hi16(raw[i][e]) * rstd * gn[8 * i + 2 * e + 1]);
              *(u32x4*)(p + 8 * i) = w; } }
#pragma unroll
        for (int i = 0; i < 4; ++i) { const int idx = tid + 512 * i, tok = idx >> 6, c8 = idx & 63;
            *(u32x4*)(vts + tok * 512 + c8 * 8) = *(const u32x4*)(((const bf16_t*)(C.ws + WS_AV)) + (size_t)(t0 + tok) * 512 + c8 * 8); }
        { const int tok = tid >> 4, i = tid & 15; gs[tok * 16 + i] = bf2f(((const bf16_t*)(C.ws + WS_GAD))[(size_t)(t0 + tok) * 16 + i]); }
        if (tid < 256) { const int j = tid, col = 1536 + j; const float m_ = mu[1536 + j];
            float prev = (s0 == 0) ? 0.f : bf2f(RWt[col - 1792]);
#pragma unroll
            for (int t = 0; t < 32; ++t) { const float x = bf2f(RWt[(size_t)t * 1792 + col]); const float mv = mixv(x, prev, m_); prev = x;
                float val; if (j < 64) { const float e2 = __expf(2.f * mv); val = 1.f - 2.f / (e2 + 1.f); } else if (j < 128) val = mv; else val = sigmoidf_(mv);
                xs[t * 264 + j] = f2bf(val); } }
        __syncthreads();
        if (!(C.flags & 32)) { u32x4 o[4];
#pragma unroll
          for (int q = 0; q < 4; ++q)
#pragma unroll
              for (int e = 0; e < 4; ++e) { const unsigned a = vts[(8 * q + 2 * e) * 512 + tid], c2 = vts[(8 * q + 2 * e + 1) * 512 + tid]; o[q][e] = a | (c2 << 16); }
          bf16_t* dst = ((bf16_t*)(C.ws + WS_VT)) + ((((size_t)b * 4 + (tid >> 7)) * 64 + (s0 >> 5)) * 128 + (tid & 127)) * 32;
#pragma unroll
          for (int q = 0; q < 4; ++q) *(u32x4*)(dst + 8 * q) = o[q]; }
        if (!(C.flags & 128)) { const int j = tid & 255, half = tid >> 8; float au[16];
#pragma unroll
          for (int i = 0; i < 16; ++i) au[i] = C.in[IN_GAUP][(size_t)l * 16 * 256 + i * 256 + j];
          const float ab = C.in[IN_GAB][l * 256 + j];
          float* la = ((float*)(C.ws + WS_LA)) + (((size_t)b * 4 + (j >> 6)) * S_ + s0) * 64 + (j & 63);
          for (int t = half * 16; t < half * 16 + 16; ++t) { float z = ab;
#pragma unroll
              for (int i = 0; i < 16; ++i) z += gs[t * 16 + i] * au[i];
              la[(size_t)t * 64] = -softplusf_(-z) * (1.f / 16.f); } }
        __syncthreads();
        if (!(C.flags & 64)) {
        const int r = lane & 31, hh = lane >> 5, w = C.wave, slot = w & 3, tile = w >> 2;
        const bf16_t* LW = ((const bf16_t*)(C.ws + WS_LW)) + (size_t)l * 512 * 256;
        const bool has_prev = !(s0 == 0 && r == 0);
        const bf16_t* xrow = RWt + (size_t)r * 1792; const bf16_t* xprev = xrow - 1792;
        float* red = (float*)(C.ldsg + PS_RED);
#pragma unroll 1
        for (int pass = 0; pass < 2; ++pass) {
            const int hd = 4 * pass + slot, ch0 = 64 * hd + 32 * tile;
            unsigned char* stg = C.ldsg + PS_STG + slot * PS_SLOT + r * 144 + (32 * tile + 4 * hh) * 2;
            float ssq = 0.f, bon = 0.f;
            f32x16 aw, aa, ag;
#pragma unroll
            for (int i = 0; i < 16; ++i) { aw[i] = 0.f; aa[i] = 0.f; ag[i] = 0.f; }
            const bf16_t* wrow = LW + (size_t)(ch0 + r) * 256 + 8 * hh;
#pragma unroll
            for (int s = 0; s < 4; ++s) aw = MFMA32(*(const bf16x8*)(wrow + 16 * s), *(const bf16x8*)(xs + r * 264 + 16 * s + 8 * hh), aw);
#pragma unroll
            for (int s = 0; s < 4; ++s) aa = MFMA32(*(const bf16x8*)(wrow + 64 + 16 * s), *(const bf16x8*)(xs + r * 264 + 64 + 16 * s + 8 * hh), aa);
#pragma unroll
            for (int s = 0; s < 8; ++s) ag = MFMA32(*(const bf16x8*)(wrow + 128 + 16 * s), *(const bf16x8*)(xs + r * 264 + 128 + 16 * s + 8 * hh), ag);
#pragma unroll
            for (int g = 0; g < 4; ++g) { const int ch = ch0 + 8 * g + 4 * hh;
                const size_t o = (size_t)(t0 + r) * 512 + ch;
                const f32x4 w0 = *(const f32x4*)(C.in[IN_W0] + l * 512 + ch), a0 = *(const f32x4*)(C.in[IN_A0] + l * 512 + ch);
                const f32x4 mur = *(const f32x4*)(mu + ch), muk = *(const f32x4*)(mu + 512 + ch), muv = *(const f32x4*)(mu + 1024 + ch);
                const f32x4 kkc = *(const f32x4*)(C.in[IN_KK] + l * 512 + ch), kac = *(const f32x4*)(C.in[IN_KA] + l * 512 + ch), rkc = *(const f32x4*)(C.in[IN_RK] + l * 512 + ch);
                const u32x2 ur = *(const u32x2*)(xrow + ch), uk = *(const u32x2*)(xrow + 512 + ch), uv = *(const u32x2*)(xrow + 1024 + ch);
                u32x2 pr = {0u, 0u}, pk = {0u, 0u}, pv = {0u, 0u};
                if (has_prev) { pr = *(const u32x2*)(xprev + ch); pk = *(const u32x2*)(xprev + 512 + ch); pv = *(const u32x2*)(xprev + 1024 + ch); }
                const float xr_[4] = {lo16(ur.x), hi16(ur.x), lo16(ur.y), hi16(ur.y)}, xk_[4] = {lo16(uk.x), hi16(uk.x), lo16(uk.y), hi16(uk.y)}, xv_[4] = {lo16(uv.x), hi16(uv.x), lo16(uv.y), hi16(uv.y)};
                const float qr_[4] = {lo16(pr.x), hi16(pr.x), lo16(pr.y), hi16(pr.y)}, qk_[4] = {lo16(pk.x), hi16(pk.x), lo16(pk.y), hi16(pk.y)}, qv_[4] = {lo16(pv.x), hi16(pv.x), lo16(pv.y), hi16(pv.y)};
                float ld4[4], g4[4], r4[4], kp4[4], v4[4], kr4[4], bb4[4];
#pragma unroll
                for (int e = 0; e < 4; ++e) { const int i = 4 * g + e;
                    const float wv = -softplusf_(-(w0[e] + aw[i])) - 0.5f; ld4[e] = -__expf(wv);
                    const float a = sigmoidf_(a0[e] + aa[i]); g4[e] = ag[i];
                    const float rr = mixv(xr_[e], qr_[e], mur[e]), kk = mixv(xk_[e], qk_[e], muk[e]), vv = mixv(xv_[e], qv_[e], muv[e]);
                    const float kk_ = kk * kkc[e]; kr4[e] = kk_; bb4[e] = kk_ * a; ssq += kk_ * kk_;
                    const float kp = kk * (1.f + (a - 1.f) * kac[e]); bon += rr * kp * rkc[e];
                    r4[e] = rr; kp4[e] = kp; v4[e] = vv; }
                *(f32x4*)(((float*)(C.ws + WS_RLD)) + o) = (f32x4){ld4[0], ld4[1], ld4[2], ld4[3]};
                u32x2 t2; unsigned char* sp = stg + 16 * g;
                t2.x = pk2(g4[0], g4[1]); t2.y = pk2(g4[2], g4[3]); *(u32x2*)(sp) = t2;
                t2.x = pk2(r4[0], r4[1]); t2.y = pk2(r4[2], r4[3]); *(u32x2*)(sp + PS_ARR) = t2;
                t2.x = pk2(kp4[0], kp4[1]); t2.y = pk2(kp4[2], kp4[3]); *(u32x2*)(sp + 2 * PS_ARR) = t2;
                t2.x = pk2(v4[0], v4[1]); t2.y = pk2(v4[2], v4[3]); *(u32x2*)(sp + 3 * PS_ARR) = t2;
                t2.x = pk2(kr4[0], kr4[1]); t2.y = pk2(kr4[2], kr4[3]); *(u32x2*)(sp + 4 * PS_ARR) = t2;
                t2.x = pk2(bb4[0], bb4[1]); t2.y = pk2(bb4[2], bb4[3]); *(u32x2*)(sp + 5 * PS_ARR) = t2;
                __builtin_amdgcn_sched_barrier(0); }
            ssq += xor32(ssq, lane); bon += xor32(bon, lane);
            if (hh == 0) { red[((slot * 2 + tile) * 32 + r) * 2] = ssq; red[((slot * 2 + tile) * 32 + r) * 2 + 1] = bon; }
            __syncthreads();
#pragma unroll 4
            for (int i = 0; i < 12; ++i) { const int P = tid + 512 * i, sl = P / 1536, rem = P - sl * 1536, arr = rem >> 8, row = (rem & 255) >> 3, piece = rem & 7;
                const u32x4 v = *(const u32x4*)(C.ldsg + PS_STG + sl * PS_SLOT + arr * PS_ARR + row * 144 + piece * 16);
                const size_t aoff = (arr == 0) ? WS_RG : (arr == 1) ? WS_RR : (arr == 2) ? WS_RK : (arr == 3) ? WS_RV : (arr == 4) ? WS_RKK : WS_RBB;
                *(u32x4*)(((bf16_t*)(C.ws + aoff)) + (size_t)(t0 + row) * 512 + (4 * pass + sl) * 64 + piece * 8) = v; }
            if (tid < 128) { const int sl = tid >> 5, tk = tid & 31;
                const float sq = red[((sl * 2) * 32 + tk) * 2] + red[((sl * 2 + 1) * 32 + tk) * 2], bn = red[((sl * 2) * 32 + tk) * 2 + 1] + red[((sl * 2 + 1) * 32 + tk) * 2 + 1];
                const float nrm = fmaxf(sqrtf(sq), 1e-12f);
                ((float*)(C.ws + WS_RC))[(size_t)(t0 + tk) * 8 + 4 * pass + sl] = 1.f / (nrm * nrm);
                ((float*)(C.ws + WS_RBON))[(size_t)(t0 + tk) * 8 + 4 * pass + sl] = bn; }
            __syncthreads();
        }
        }
        __syncthreads();
    }
}

constexpr int RW_WGS = 128;
__device__ __forceinline__ void rwkv_wg(const Ctx& C0, int l, int item) {
    Ctx C = C0; fresh(C);
    const int bh = item >> 1, rh = item & 1, b = bh >> 3, h = bh & 7, tid = C.tid, lane = C.lane;
    float* dec = (float*)C.ldsg; float* skk = dec + 2048; float* sbb = dec + 4096; float* skp = dec + 6144; float* srr = dec + 8192;
    bf16_t* svv = (bf16_t*)(C.ldsg + 40960);
    float* yb = (float*)(C.ldsg + 45056);
    const int rloc = 4 * C.wave + (lane >> 4), row = 32 * rh + rloc, kq = lane & 15;
    float s0 = 0.f, s1 = 0.f, s2 = 0.f, s3 = 0.f;
    const int lstep = tid >> 4, lc4 = tid & 15;
    const size_t o0 = ((size_t)b * S_ + lstep) * 512 + h * 64 + 4 * lc4; const int lo = lstep * 64 + 4 * lc4;
    f32x4 nld = *(const f32x4*)(((const float*)(C.ws + WS_RLD)) + o0);
    u32x2 nkk = *(const u32x2*)(((const bf16_t*)(C.ws + WS_RKK)) + o0), nbb = *(const u32x2*)(((const bf16_t*)(C.ws + WS_RBB)) + o0), nkp = *(const u32x2*)(((const bf16_t*)(C.ws + WS_RK)) + o0),
          nrr = *(const u32x2*)(((const bf16_t*)(C.ws + WS_RR)) + o0), nvv = *(const u32x2*)(((const bf16_t*)(C.ws + WS_RV)) + o0);
    float ncs = ((const float*)(C.ws + WS_RC))[((size_t)b * S_ + lstep) * 8 + h];
    for (int blk = 0; blk < S_ / 32; ++blk) {
        const size_t tb = (size_t)b * S_ + blk * 32;
        { f32x4 d; d[0] = __expf(nld[0]); d[1] = __expf(nld[1]); d[2] = __expf(nld[2]); d[3] = __expf(nld[3]);
          *(f32x4*)(dec + lo) = d;
          *(f32x4*)(skk + lo) = (f32x4){lo16(nkk.x), hi16(nkk.x), lo16(nkk.y), hi16(nkk.y)};
          *(f32x4*)(sbb + lo) = (f32x4){lo16(nbb.x) * ncs, hi16(nbb.x) * ncs, lo16(nbb.y) * ncs, hi16(nbb.y) * ncs};
          *(f32x4*)(skp + lo) = (f32x4){lo16(nkp.x), hi16(nkp.x), lo16(nkp.y), hi16(nkp.y)};
          *(f32x4*)(srr + lo) = (f32x4){lo16(nrr.x), hi16(nrr.x), lo16(nrr.y), hi16(nrr.y)};
          *(u32x2*)(svv + lo) = nvv; }
        __syncthreads();
        if (blk + 1 < S_ / 32) { const size_t o = o0 + (size_t)(blk + 1) * 32 * 512;
            nld = *(const f32x4*)(((const float*)(C.ws + WS_RLD)) + o);
            nkk = *(const u32x2*)(((const bf16_t*)(C.ws + WS_RKK)) + o); nbb = *(const u32x2*)(((const bf16_t*)(C.ws + WS_RBB)) + o); nkp = *(const u32x2*)(((const bf16_t*)(C.ws + WS_RK)) + o);
            nrr = *(const u32x2*)(((const bf16_t*)(C.ws + WS_RR)) + o); nvv = *(const u32x2*)(((const bf16_t*)(C.ws + WS_RV)) + o);
            ncs = ((const float*)(C.ws + WS_RC))[(tb + 32 + lstep) * 8 + h]; }
#pragma unroll
        for (int tg = 0; tg < 2; ++tg) {
            float ykeep = 0.f;
#pragma unroll
            for (int tt = 0; tt < 16; ++tt) { const int t = 16 * tg + tt;
                const f32x4 dc = *(const f32x4*)(dec + t * 64 + 4 * kq), kk = *(const f32x4*)(skk + t * 64 + 4 * kq), bb = *(const f32x4*)(sbb + t * 64 + 4 * kq),
                            kp = *(const f32x4*)(skp + t * 64 + 4 * kq), rr = *(const f32x4*)(srr + t * 64 + 4 * kq);
                const float vr = bf2f(svv[t * 64 + row]);
                float sa = (s0 * kk[0] + s1 * kk[1]) + (s2 * kk[2] + s3 * kk[3]);
                const float t0_ = s0 * dc[0] + vr * kp[0], t1_ = s1 * dc[1] + vr * kp[1], t2_ = s2 * dc[2] + vr * kp[2], t3_ = s3 * dc[3] + vr * kp[3];
                sa = sum16(sa);
                s0 = t0_ - sa * bb[0]; s1 = t1_ - sa * bb[1]; s2 = t2_ - sa * bb[2]; s3 = t3_ - sa * bb[3];
                float y = (s0 * rr[0] + s1 * rr[1]) + (s2 * rr[2] + s3 * rr[3]);
                y = sum16(y);
                ykeep = (kq == tt) ? y : ykeep;
            }
            yb[(16 * tg + kq) * 32 + rloc] = ykeep;
        }
        __syncthreads();
        { const int st = tid >> 4, c2 = (tid & 15) * 2;
          float* yo = ((float*)(C.ws + WS_RY)) + (tb + st) * 512 + h * 64 + 32 * rh + c2;
          *(float2*)yo = *(const float2*)(yb + st * 32 + c2); }
    }
}
__device__ __forceinline__ void rwkv_finish(const Ctx& C, int l) {
    const int gw = C.bid * NWAVES + C.wave, NGW = C.G * NWAVES, lane = C.lane;
    const float* lng = C.in[IN_LNG] + l * 512; const float* lnb = C.in[IN_LNB] + l * 512;
    for (int t = gw; t < T_; t += NGW) {
        const float* yp = ((const float*)(C.ws + WS_RY)) + (size_t)t * 512 + 8 * lane;
        const f32x4 y0 = *(const f32x4*)yp, y1 = *(const f32x4*)(yp + 4);
        float sm = (y0[0] + y0[1] + y0[2] + y0[3]) + (y1[0] + y1[1] + y1[2] + y1[3]);
        sm = sum8(sm); const float mean = sm * (1.f / 64.f);
        float e[8];
#pragma unroll
        for (int i = 0; i < 4; ++i) { e[i] = y0[i] - mean; e[4 + i] = y1[i] - mean; }
        float vs = 0.f;
#pragma unroll
        for (int i = 0; i < 8; ++i) vs += e[i] * e[i];
        vs = sum8(vs); const float rstd = rsqrtf(vs * (1.f / 64.f) + 64e-5f);
        const float bon = ((const float*)(C.ws + WS_RBON))[(size_t)t * 8 + (lane >> 3)];
        const u32x4 uv = *(const u32x4*)(((const bf16_t*)(C.ws + WS_RV)) + (size_t)t * 512 + 8 * lane), ug = *(const u32x4*)(((const bf16_t*)(C.ws + WS_RG)) + (size_t)t * 512 + 8 * lane);
        float o[8];
#pragma unroll
        for (int i = 0; i < 4; ++i) { const int c = 8 * lane + 2 * i;
            o[2 * i] = (e[2 * i] * rstd * lng[c] + lnb[c] + bon * lo16(uv[i])) * lo16(ug[i]);
            o[2 * i + 1] = (e[2 * i + 1] * rstd * lng[c + 1] + lnb[c + 1] + bon * hi16(uv[i])) * hi16(ug[i]); }
        u32x4 w; w.x = pk2(o[0], o[1]); w.y = pk2(o[2], o[3]); w.z = pk2(o[4], o[5]); w.w = pk2(o[6], o[7]);
        *(u32x4*)(((bf16_t*)(C.ws + WS_OR)) + (size_t)t * 512 + 8 * lane) = w;
    }
}

constexpr int GL_BC = 0, GL_QT = 16896, GL_KT = 26112, GL_KHT = 35328, GL_VT = 44544, GL_ST = 62976, GL_PM = 81408, GL_OB = 90624, GL_GT = 124416, GL_LD = 72, GL_BS = 65;
__device__ __forceinline__ bf16x8 ldfrag(const LAS unsigned char* lds, int off, int row0, int k0, int lane) {
    return *(const LAS bf16x8*)(lds + off + ((row0 + (lane & 31)) * GL_LD + k0 + 8 * (lane >> 5)) * 2);
}
__device__ __forceinline__ void gla_wg(const Ctx& C0, int l, int bh) {
    Ctx C = C0; fresh(C);
    const int h = bh & 3, tid = C.tid, lane = C.lane, w = C.wave, r = lane & 31, hh = lane >> 5;
    float* Bc = (float*)(C.ldsg + GL_BC);
    bf16_t* Qt = (bf16_t*)(C.ldsg + GL_QT); bf16_t* Kt = (bf16_t*)(C.ldsg + GL_KT); bf16_t* KhT = (bf16_t*)(C.ldsg + GL_KHT);
    bf16_t* VTs = (bf16_t*)(C.ldsg + GL_VT); bf16_t* STs = (bf16_t*)(C.ldsg + GL_ST); bf16_t* Pm = (bf16_t*)(C.ldsg + GL_PM);
    float* Ob = (float*)(C.ldsg + GL_OB);
    float* Gt = (float*)(C.ldsg + GL_GT);
    for (int i = tid; i < 128 * GL_LD / 2; i += NTHR) ((unsigned*)STs)[i] = 0u;
    f32x16 st;
#pragma unroll
    for (int i = 0; i < 16; ++i) st[i] = 0.f;
    const float* gng = C.in[IN_GNG] + l * 128;
    const size_t hb = (size_t)bh * S_;
    const int bi = tid >> 3, e16 = (tid & 7) * 16;
    const int li = tid & 63, ld8 = (tid >> 6) * 8, le16 = (tid >> 6) * 16;
    const int pd = tid & 63, pg = tid >> 6;
    u32x4 nq = *(const u32x4*)(((const bf16_t*)(C.ws + WS_GQ)) + (hb + li) * 64 + ld8), nk = *(const u32x4*)(((const bf16_t*)(C.ws + WS_GK)) + (hb + li) * 64 + ld8);
    u32x4 nv0 = *(const u32x4*)(((const bf16_t*)(C.ws + WS_GV)) + (hb + li) * 128 + le16), nv1 = *(const u32x4*)(((const bf16_t*)(C.ws + WS_GV)) + (hb + li) * 128 + le16 + 8);
    float nla[8];
#pragma unroll
    for (int i = 0; i < 8; ++i) nla[i] = ((const float*)(C.ws + WS_LA))[(hb + 8 * pg + i) * 64 + pd];
    __syncthreads();
    for (int c = 0; c < S_ / 64; ++c) {
        const size_t tb = hb + c * 64;
        const u32x4 uq = nq, uk = nk, v0 = nv0, v1 = nv1;
        float lp[8]; { float run = 0.f;
#pragma unroll
            for (int i = 0; i < 8; ++i) { run += nla[i]; lp[i] = run; }
            Gt[pg * 64 + pd] = run; }
        const u32x4 g0 = *(const u32x4*)(((const bf16_t*)(C.ws + WS_GG)) + (tb + bi) * 128 + e16), g1 = *(const u32x4*)(((const bf16_t*)(C.ws + WS_GG)) + (tb + bi) * 128 + e16 + 8);
        if (c + 1 < S_ / 64) { const size_t tn = tb + 64;
            nq = *(const u32x4*)(((const bf16_t*)(C.ws + WS_GQ)) + (tn + li) * 64 + ld8); nk = *(const u32x4*)(((const bf16_t*)(C.ws + WS_GK)) + (tn + li) * 64 + ld8);
            nv0 = *(const u32x4*)(((const bf16_t*)(C.ws + WS_GV)) + (tn + li) * 128 + le16); nv1 = *(const u32x4*)(((const bf16_t*)(C.ws + WS_GV)) + (tn + li) * 128 + le16 + 8);
#pragma unroll
            for (int i = 0; i < 8; ++i) nla[i] = ((const float*)(C.ws + WS_LA))[(tn + 8 * pg + i) * 64 + pd]; }
        __syncthreads();
        { float off = 0.f;
#pragma unroll
          for (int g = 0; g < 7; ++g) off += (g < pg) ? Gt[g * 64 + pd] : 0.f;
#pragma unroll
          for (int i = 0; i < 8; ++i) Bc[(8 * pg + i) * GL_BS + pd] = off + lp[i]; }
        __syncthreads();
        { const int i = li, d8 = ld8, e16b = le16;
          float q[8], k[8];
#pragma unroll
          for (int e = 0; e < 4; ++e) { q[2 * e] = lo16(uq[e]); q[2 * e + 1] = hi16(uq[e]); k[2 * e] = lo16(uk[e]); k[2 * e + 1] = hi16(uk[e]); }
          float qt[8], kt[8];
#pragma unroll
          for (int e = 0; e < 8; ++e) { const float bb = Bc[i * GL_BS + d8 + e], bl = Bc[63 * GL_BS + d8 + e];
              qt[e] = q[e] * 0.125f * __expf(bb); kt[e] = k[e] * __expf(-bb); KhT[(d8 + e) * GL_LD + i] = f2bf(k[e] * __expf(bl - bb)); }
          u32x4 wq, wk;
#pragma unroll
          for (int e = 0; e < 4; ++e) { wq[e] = pk2(qt[2 * e], qt[2 * e + 1]); wk[e] = pk2(kt[2 * e], kt[2 * e + 1]); }
          *(u32x4*)(Qt + i * GL_LD + d8) = wq; *(u32x4*)(Kt + i * GL_LD + d8) = wk;
#pragma unroll
          for (int e = 0; e < 4; ++e) { VTs[(e16b + 2 * e) * GL_LD + i] = (bf16_t)(v0[e] & 0xffffu); VTs[(e16b + 2 * e + 1) * GL_LD + i] = (bf16_t)(v0[e] >> 16);
              VTs[(e16b + 8 + 2 * e) * GL_LD + i] = (bf16_t)(v1[e] & 0xffffu); VTs[(e16b + 8 + 2 * e + 1) * GL_LD + i] = (bf16_t)(v1[e] >> 16); } }
        __syncthreads();
        if (w < 4) { const int ti = w >> 1, tj = w & 1; f32x16 a;
#pragma unroll
            for (int i = 0; i < 16; ++i) a[i] = 0.f;
            if (!(ti == 0 && tj == 1)) {
#pragma unroll
                for (int s = 0; s < 4; ++s) a = MFMA32(ldfrag(C.lds, GL_QT, 32 * ti, 16 * s, lane), ldfrag(C.lds, GL_KT, 32 * tj, 16 * s, lane), a); }
#pragma unroll
            for (int i = 0; i < 16; ++i) { const int ii = 32 * ti + crow(i, hh), jj = 32 * tj + r; Pm[ii * GL_LD + jj] = f2bf(jj <= ii ? a[i] : 0.f); } }
        { const int te = w >> 1, td = w & 1; const float dl = __expf(Bc[63 * GL_BS + 32 * td + r]);
#pragma unroll
          for (int i = 0; i < 16; ++i) st[i] *= dl;
#pragma unroll
          for (int s = 0; s < 4; ++s) st = MFMA32(ldfrag(C.lds, GL_VT, 32 * te, 16 * s, lane), ldfrag(C.lds, GL_KHT, 32 * td, 16 * s, lane), st); }
        __syncthreads();
        { const int ti = w >> 2, te = w & 3; f32x16 a;
#pragma unroll
          for (int i = 0; i < 16; ++i) a[i] = 0.f;
#pragma unroll
          for (int s = 0; s < 4; ++s) a = MFMA32(ldfrag(C.lds, GL_PM, 32 * ti, 16 * s, lane), ldfrag(C.lds, GL_VT, 32 * te, 16 * s, lane), a);
#pragma unroll
          for (int s = 0; s < 4; ++s) a = MFMA32(ldfrag(C.lds, GL_QT, 32 * ti, 16 * s, lane), ldfrag(C.lds, GL_ST, 32 * te, 16 * s, lane), a);
#pragma unroll
          for (int i = 0; i < 16; ++i) Ob[(32 * ti + crow(i, hh)) * 132 + 32 * te + r] = a[i]; }
        __syncthreads();
        { const int te = w >> 1, td = w & 1;
#pragma unroll
          for (int i = 0; i < 16; ++i) STs[(32 * te + crow(i, hh)) * GL_LD + 32 * td + r] = f2bf(st[i]); }
        { const int i = bi; float o[16]; float ss = 0.f;
#pragma unroll
          for (int q = 0; q < 4; ++q) { const f32x4 x = *(const f32x4*)(Ob + i * 132 + e16 + 4 * q); o[4 * q] = x[0]; o[4 * q + 1] = x[1]; o[4 * q + 2] = x[2]; o[4 * q + 3] = x[3]; ss += x[0] * x[0] + x[1] * x[1] + x[2] * x[2] + x[3] * x[3]; }
          ss = sum8(ss);
          const float rstd = rsqrtf(ss * (1.f / 128.f) + 1e-6f);
          float gt[16];
#pragma unroll
          for (int e = 0; e < 4; ++e) { gt[2 * e] = lo16(g0[e]); gt[2 * e + 1] = hi16(g0[e]); gt[8 + 2 * e] = lo16(g1[e]); gt[8 + 2 * e + 1] = hi16(g1[e]); }
#pragma unroll
          for (int e = 0; e < 16; ++e) o[e] = o[e] * rstd * gng[e16 + e] * siluf_(gt[e]);
          u32x4 w0, w1;
#pragma unroll
          for (int e = 0; e < 4; ++e) { w0[e] = pk2(o[2 * e], o[2 * e + 1]); w1[e] = pk2(o[8 + 2 * e], o[8 + 2 * e + 1]); }
          bf16_t* dst = ((bf16_t*)(C.ws + WS_OG)) + ((size_t)(bh >> 2) * S_ + c * 64 + i) * 512 + h * 128 + e16;
          *(u32x4*)dst = w0; *(u32x4*)(dst + 8) = w1; }
        __syncthreads();
    }
}

constexpr int AT_Q = 0, AT_K = 65536, AT_V = 65536 + 18432, AT_KLD = 72, AT_VLD = 36;
__device__ __forceinline__ void attn_wg(const Ctx& C0, int l, int bh, int jb, float lam, float lam_init) {
    Ctx C = C0; fresh(C);
    const int b = bh >> 2, h = bh & 3, tid = C.tid, lane = C.lane, r = lane & 31, hh = lane >> 5, j = 8 * jb + C.wave;
    LAS bf16x8* qs = (LAS bf16x8*)(C.lds + AT_Q + C.wave * 8192) + lane;
#pragma unroll
    for (int cc = 0; cc < 2; ++cc)
#pragma unroll
        for (int s = 0; s < 4; ++s) qs[64 * (cc * 4 + s)] = *(const bf16x8*)(((const bf16_t*)(C.ws + WS_QH)) + (((size_t)b * 8 + h * 2 + cc) * S_ + 32 * j + r) * 64 + 16 * s + 8 * hh);
    f32x16 O[2][4];
#pragma unroll
    for (int cc = 0; cc < 2; ++cc)
#pragma unroll
        for (int k = 0; k < 4; ++k)
#pragma unroll
            for (int i = 0; i < 16; ++i) O[cc][k][i] = 0.f;
    float mrun[2] = {-INFINITY, -INFINITY}, lsum[2] = {0.f, 0.f};
    const float slope = exp2f(-2.f * (float)(h + 1));
    const int qpos = 32 * j + r;
    const int kcc = tid >> 8, kkey = (tid >> 3) & 31, kc = tid & 7, ve = tid >> 2, vc = tid & 3;
    const bf16_t* kg = ((const bf16_t*)(C.ws + WS_KH)) + (((size_t)b * 8 + h * 2 + kcc) * S_ + kkey) * 64 + 8 * kc;
    const bf16_t* vg = ((const bf16_t*)(C.ws + WS_VT)) + (((size_t)b * 4 + h) * 64) * 4096 + ve * 32 + 8 * vc;
    const int klo = AT_K + ((kcc * 32 + kkey) * AT_KLD + 8 * kc) * 2, vlo = AT_V + (ve * AT_VLD + 8 * vc) * 2;
    const int ntiles = 8 * jb + 8;
    u32x4 kreg = *(const u32x4*)kg, vreg = *(const u32x4*)vg;
    for (int kt = 0; kt < ntiles; ++kt) {
        const int boff = (kt & 1) * 9216;
        *(LAS u32x4*)(C.lds + klo + boff) = kreg;
        { LAS u32x2* vd = (LAS u32x2*)(C.lds + vlo + boff); u32x2 a, c2; a.x = vreg.x; a.y = vreg.y; c2.x = vreg.z; c2.y = vreg.w; vd[0] = a; vd[1] = c2; }
        if (kt + 1 < ntiles) { kreg = *(const u32x4*)(kg + (size_t)(kt + 1) * 32 * 64); vreg = *(const u32x4*)(vg + (size_t)(kt + 1) * 4096); }
        __syncthreads();
        if (kt <= j) {
            const LAS unsigned char* kb = C.lds + AT_K + boff; const LAS unsigned char* vb = C.lds + AT_V + boff;
#pragma unroll
            for (int cc = 0; cc < 2; ++cc) {
                f32x16 sc;
#pragma unroll
                for (int i = 0; i < 16; ++i) sc[i] = 0.f;
#pragma unroll
                for (int s = 0; s < 4; ++s) { const bf16x8 kf = *(const LAS bf16x8*)(kb + ((cc * 32 + r) * AT_KLD + 16 * s + 8 * hh) * 2); sc = MFMA32(kf, qs[64 * (cc * 4 + s)], sc); }
                float mx = -INFINITY;
#pragma unroll
                for (int i = 0; i < 16; ++i) { const int dist = qpos - (32 * kt + crow(i, hh)); float v = sc[i] - slope * (float)dist; v = (dist < 0) ? -INFINITY : v; sc[i] = v; mx = fmaxf(mx, v); }
                mx = fmaxf(mx, xor32(mx, lane));
                const float mnew = fmaxf(mrun[cc], mx);
                float ps = 0.f;
#pragma unroll
                for (int i = 0; i < 16; ++i) { const float p = __expf(sc[i] - mnew); sc[i] = p; ps += p; }
                ps += xor32(ps, lane);
                if (__any(mnew > mrun[cc])) {
                    const float alpha = __expf(mrun[cc] - mnew);
                    lsum[cc] *= alpha;
#pragma unroll
                    for (int k = 0; k < 4; ++k)
#pragma unroll
                        for (int i = 0; i < 16; ++i) O[cc][k][i] *= alpha;
                }
                lsum[cc] += ps; mrun[cc] = mnew;
                bf16x8 pb[2];
#pragma unroll
                for (int s2 = 0; s2 < 2; ++s2) { u32x4 t; t.x = pk2(sc[8 * s2], sc[8 * s2 + 1]); t.y = pk2(sc[8 * s2 + 2], sc[8 * s2 + 3]); t.z = pk2(sc[8 * s2 + 4], sc[8 * s2 + 5]); t.w = pk2(sc[8 * s2 + 6], sc[8 * s2 + 7]); pb[s2] = __builtin_bit_cast(bf16x8, t); }
#pragma unroll
                for (int k = 0; k < 4; ++k)
#pragma unroll
                    for (int s2 = 0; s2 < 2; ++s2) { const LAS unsigned char* vp = vb + ((32 * k + r) * AT_VLD + 16 * s2 + 4 * hh) * 2;
                        const u32x2 lo = *(const LAS u32x2*)vp, hi = *(const LAS u32x2*)(vp + 16);
                        u32x4 t; t.x = lo.x; t.y = lo.y; t.z = hi.x; t.w = hi.y;
                        O[cc][k] = MFMA32(__builtin_bit_cast(bf16x8, t), pb[s2], O[cc][k]); }
                __builtin_amdgcn_sched_barrier(0);
            }
        }
    }
    const float i1 = 1.f / lsum[0], i2 = lam / lsum[1];
    float ss = 0.f;
#pragma unroll
    for (int k = 0; k < 4; ++k)
#pragma unroll
        for (int i = 0; i < 16; ++i) { const float o = O[0][k][i] * i1 - O[1][k][i] * i2; O[0][k][i] = o; ss += o * o; }
    ss += xor32(ss, lane);
    const float rs = rsqrtf(ss * (1.f / 128.f) + 1e-6f) * (1.f - lam_init);
    const float* sg = C.in[IN_SUBLN] + l * 128;
    bf16_t* dst = ((bf16_t*)(C.ws + WS_OA)) + (size_t)(b * S_ + 32 * j + r) * 512 + h * 128;
#pragma unroll
    for (int k = 0; k < 4; ++k)
#pragma unroll
        for (int g = 0; g < 4; ++g) { const int dv = 32 * k + 8 * g + 4 * hh; const f32x4 gg = *(const f32x4*)(sg + dv);
            u32x2 w; w.x = pk2(O[0][k][4 * g] * rs * gg[0], O[0][k][4 * g + 1] * rs * gg[1]); w.y = pk2(O[0][k][4 * g + 2] * rs * gg[2], O[0][k][4 * g + 3] * rs * gg[3]);
            *(u32x2*)(dst + dv) = w; }
    __syncthreads();
}

__device__ __forceinline__ void gate_units(const Ctx& C0, int l) {
    Ctx C = C0; fresh(C);
    __syncthreads();
    GateOrder S; S.A = (const char*)(C.ws + WS_H); S.B = (const char*)(((const bf16_t*)(C.ws + WS_WIN)) + (size_t)l * NP_ * 1024); { const int a = C.bid - 128; S.q = (a & 7) * 16 + (a >> 3); }
    EpiP E{C.ws};
    pg8::gemm_phase<EpiP, GateOrder, false>(C.lds, C.tid, 1024, 2048u, 2048u, S, E);
}
__device__ __forceinline__ void phase_mixers(const Ctx& C, int l) {
#ifndef REP_R
#define REP_R 1
#define REP_G 1
#define REP_A 1
#endif
    if (C.bid < 128) { for (int rep = 0; rep < REP_R; ++rep) rwkv_wg(C, l, C.bid); return; }
    if (C.bid < 160) { for (int rep = 0; rep < REP_G; ++rep) gla_wg(C, l, C.bid - 128); gate_units(C, l); return; }
    const float lam_init = 0.8f - 0.6f * __expf(-0.3f * (float)l);
    const float* lv = C.in[IN_LAM] + l * 256;
    const float d0 = wave_sum(lv[C.lane] * lv[64 + C.lane]), d1 = wave_sum(lv[128 + C.lane] * lv[192 + C.lane]);
    const float lam = __expf(d0) - __expf(d1) + lam_init;
    {
        const int a = C.bid - 160, grp = a >> 5, bh = a & 31;
        for (int rep = 0; rep < REP_A; ++rep) {
            if (grp == 0) { attn_wg(C, l, bh, 7, lam, lam_init); attn_wg(C, l, bh, 3, lam, lam_init); }
            else if (grp == 1) { attn_wg(C, l, bh, 6, lam, lam_init); attn_wg(C, l, bh, 4, lam, lam_init); }
            else { attn_wg(C, l, bh, 5, lam, lam_init); attn_wg(C, l, bh, 2, lam, lam_init); attn_wg(C, l, bh, 1, lam, lam_init); attn_wg(C, l, bh, 0, lam, lam_init); }
        }
    }
    gate_units(C, l);
}

__device__ __forceinline__ int rcount_of(int wave, int bid, int G) { const int gw = bid * NWAVES + wave, NGW = G * NWAVES; return gw < T_ ? (T_ - 1 - gw) / NGW + 1 : 0; }
constexpr int RT_WSTR = 2064, RT_WH = 0, RT_WL = 36 * RT_WSTR, RT_GMV = 149504, RT_SHV = RT_GMV + 4096, RT_RR = RT_SHV + 4096;
constexpr int RT_PL = 0, RT_SS = 18432, RT_CBX = 19456, RT_CGW = 27648, RT_CB = 27776;
static_assert(RT_WL + 36 * RT_WSTR <= RT_GMV && RT_RR + 2048 <= LDS_CTL, "route LDS map");
__device__ __forceinline__ void phase_route(const Ctx& C, int l) {
    const int lane = C.lane, wave = C.wave, tid = C.tid;
    float* gmv = (float*)(C.ldsg + RT_GMV); float* shv = (float*)(C.ldsg + RT_SHV);
    int* rr_e = (int*)(C.ldsg + RT_RR); float* rr_w = (float*)(C.ldsg + RT_RR + 512); int* rr_t = (int*)(C.ldsg + RT_RR + 1024);
    int* lcnt = (int*)(C.ldsg + RT_RR + 1280); int* lbase = (int*)(C.ldsg + RT_RR + 1408); float* rsd = (float*)(C.ldsg + RT_RR + 1536);
    const int gw = C.bid * NWAVES + C.wave, NGW = C.G * NWAVES;
    for (int slab = C.bid; slab < T_ / 64; slab += C.G) {
        const int b = (64 * slab) >> 11; const float* md = ((float*)(C.ws + WS_MOD)) + ((size_t)l * 8 + b) * 6144;
        __syncthreads();
        for (int k = tid; k < 1024; k += NTHR) { gmv[k] = C.in[IN_N2G][l * 1024 + k] * (1.f + md[4096 + k]); shv[k] = md[3072 + k]; }
        __syncthreads();
        float cbp[4] = {0.f, 0.f, 0.f, 0.f}, cgp[4] = {0.f, 0.f, 0.f, 0.f};
        { const float* ew = C.in[IN_REW] + (size_t)l * 1024 * 32; const float* gw_ = C.in[IN_RGW] + (size_t)l * 1024 * 4;
#pragma unroll 8
          for (int j = 0; j < 16; ++j) { const int i = tid + NTHR * j, k = i >> 3, qd = i & 7; const f32x4 w4 = *(const f32x4*)(ew + 4 * i); const float a = gmv[k], s = shv[k];
#pragma unroll
              for (int c = 0; c < 4; ++c) { const float v = a * w4[c]; const bf16_t h = f2bf(v), lo = f2bf(v - bf2f(h)); const int o = (4 + 4 * qd + c) * RT_WSTR + 2 * k;
                  *(LAS bf16_t*)(C.lds + RT_WH + o) = h; *(LAS bf16_t*)(C.lds + RT_WL + o) = lo; cbp[c] += s * w4[c]; } }
#pragma unroll
          for (int j = 0; j < 2; ++j) { const int k = tid + NTHR * j; const f32x4 w4 = *(const f32x4*)(gw_ + 4 * k); const float a = gmv[k], s = shv[k];
#pragma unroll
              for (int c = 0; c < 4; ++c) { const float v = a * w4[c]; const bf16_t h = f2bf(v), lo = f2bf(v - bf2f(h)); const int o = c * RT_WSTR + 2 * k;
                  *(LAS bf16_t*)(C.lds + RT_WH + o) = h; *(LAS bf16_t*)(C.lds + RT_WL + o) = lo; cgp[c] += s * w4[c]; } } }
        __syncthreads();
        { const int rg = wave & 3, kh = wave >> 2, r16 = lane & 15, q = lane >> 4;
          const float* xp = C.out + (size_t)(64 * slab + 16 * rg + r16) * 1024 + 512 * kh + 8 * q;
          f32x4 acc0 = {0.f, 0.f, 0.f, 0.f}, acc1 = acc0, acc2 = acc0; float ss = 0.f;
          const int n2 = (32 + r16 < 36) ? 32 + r16 : 35;
          const LAS unsigned char* wb = C.lds + (512 * kh + 8 * q) * 2;
          const LAS unsigned char* w0p = wb + r16 * RT_WSTR; const LAS unsigned char* w1p = wb + (16 + r16) * RT_WSTR; const LAS unsigned char* w2p = wb + n2 * RT_WSTR;
          f32x4 v0 = *(const f32x4*)xp, v1 = *(const f32x4*)(xp + 4);
#pragma unroll 2
          for (int kb = 0; kb < 16; ++kb) {
              const f32x4 c0 = v0, c1 = v1;
              if (kb + 1 < 16) { v0 = *(const f32x4*)(xp + 32 * (kb + 1)); v1 = *(const f32x4*)(xp + 32 * (kb + 1) + 4); }
              ss += c0[0] * c0[0] + c0[1] * c0[1] + c0[2] * c0[2] + c0[3] * c0[3] + c1[0] * c1[0] + c1[1] * c1[1] + c1[2] * c1[2] + c1[3] * c1[3];
              u32x4 hu, lu;
              hu.x = pk2(c0[0], c0[1]); hu.y = pk2(c0[2], c0[3]); hu.z = pk2(c1[0], c1[1]); hu.w = pk2(c1[2], c1[3]);
              lu.x = pk2(c0[0] - lo16(hu.x), c0[1] - hi16(hu.x)); lu.y = pk2(c0[2] - lo16(hu.y), c0[3] - hi16(hu.y));
              lu.z = pk2(c1[0] - lo16(hu.z), c1[1] - hi16(hu.z)); lu.w = pk2(c1[2] - lo16(hu.w), c1[3] - hi16(hu.w));
              const bf16x8 ah = __builtin_bit_cast(bf16x8, hu), al = __builtin_bit_cast(bf16x8, lu);
              const int ko = 64 * kb;
              const bf16x8 bh0 = *(const LAS bf16x8*)(w0p + RT_WH + ko), bl0 = *(const LAS bf16x8*)(w0p + RT_WL + ko);
              const bf16x8 bh1 = *(const LAS bf16x8*)(w1p + RT_WH + ko), bl1 = *(const LAS bf16x8*)(w1p + RT_WL + ko);
              const bf16x8 bh2 = *(const LAS bf16x8*)(w2p + RT_WH + ko), bl2 = *(const LAS bf16x8*)(w2p + RT_WL + ko);
              acc0 = __builtin_amdgcn_mfma_f32_16x16x32_bf16(ah, bh0, acc0, 0, 0, 0); acc0 = __builtin_amdgcn_mfma_f32_16x16x32_bf16(ah, bl0, acc0, 0, 0, 0); acc0 = __builtin_amdgcn_mfma_f32_16x16x32_bf16(al, bh0, acc0, 0, 0, 0);
              acc1 = __builtin_amdgcn_mfma_f32_16x16x32_bf16(ah, bh1, acc1, 0, 0, 0); acc1 = __builtin_amdgcn_mfma_f32_16x16x32_bf16(ah, bl1, acc1, 0, 0, 0); acc1 = __builtin_amdgcn_mfma_f32_16x16x32_bf16(al, bh1, acc1, 0, 0, 0);
              acc2 = __builtin_amdgcn_mfma_f32_16x16x32_bf16(ah, bh2, acc2, 0, 0, 0); acc2 = __builtin_amdgcn_mfma_f32_16x16x32_bf16(ah, bl2, acc2, 0, 0, 0); acc2 = __builtin_amdgcn_mfma_f32_16x16x32_bf16(al, bh2, acc2, 0, 0, 0);
          }
          ss += __int_as_float(__builtin_amdgcn_ds_bpermute((lane ^ 16) << 2, __float_as_int(ss)));
          ss += __int_as_float(__builtin_amdgcn_ds_bpermute((lane ^ 32) << 2, __float_as_int(ss)));
          __syncthreads();
          float* PL = (float*)(C.ldsg + RT_PL); float* SS = (float*)(C.ldsg + RT_SS); float* CBX = (float*)(C.ldsg + RT_CBX); float* CGW = (float*)(C.ldsg + RT_CGW);
#pragma unroll
          for (int jj = 0; jj < 4; ++jj) { float* pr = PL + (kh * 64 + 16 * rg + 4 * q + jj) * 36;
              pr[r16] = acc0[jj]; pr[16 + r16] = acc1[jj]; if (r16 < 4) pr[32 + r16] = acc2[jj]; }
          if (q == 0) SS[kh * 64 + 16 * rg + r16] = ss;
#pragma unroll
          for (int c = 0; c < 4; ++c) { CBX[(tid >> 3) * 32 + 4 * (tid & 7) + c] = cbp[c]; const float g = wave_sum(cgp[c]); if (lane == 0) CGW[wave * 4 + c] = g; }
        }
        __syncthreads();
        { float* CBX = (float*)(C.ldsg + RT_CBX); float* CGW = (float*)(C.ldsg + RT_CGW); float* CB = (float*)(C.ldsg + RT_CB);
          if (tid < 32) { float s = 0.f;
#pragma unroll 8
              for (int kg = 0; kg < 64; ++kg) s += CBX[kg * 32 + tid];
              CB[4 + tid] = s + C.in[IN_REB][l * 32 + tid]; }
          else if (tid < 36) { const int c = tid - 32; float s = 0.f;
#pragma unroll
              for (int w = 0; w < 8; ++w) s += CGW[w * 4 + c];
              CB[c] = s + C.in[IN_RGB][l * 4 + c]; } }
        __syncthreads();
        if (tid < 64) {
            const float* PL = (const float*)(C.ldsg + RT_PL); const float* SS = (const float*)(C.ldsg + RT_SS); const float* CB = (const float*)(C.ldsg + RT_CB);
            const int row = tid; const float rstd = rsqrtf((SS[row] + SS[64 + row]) * (1.f / 1024.f) + 1e-6f); rsd[row] = rstd;
            float acc[36];
#pragma unroll
            for (int o = 0; o < 36; ++o) acc[o] = rstd * (PL[row * 36 + o] + PL[(64 + row) * 36 + o]) + CB[o];
            int grp = 0; float gm = acc[0];
#pragma unroll
            for (int g = 1; g < 4; ++g) if (acc[g] > gm) { gm = acc[g]; grp = g; }
            float gsum = 0.f;
#pragma unroll
            for (int g = 0; g < 4; ++g) gsum += __expf(acc[g] - gm);
            const float gprob = 1.f / gsum;
            float ev[8];
            const float mg0 = (grp == 0) ? 1.f : 0.f, mg1 = (grp == 1) ? 1.f : 0.f, mg2 = (grp == 2) ? 1.f : 0.f, mg3 = (grp == 3) ? 1.f : 0.f;
#pragma unroll
            for (int e = 0; e < 8; ++e) ev[e] = mg0 * acc[4 + e] + mg1 * acc[12 + e] + mg2 * acc[20 + e] + mg3 * acc[28 + e];
            int i0 = 0; float v0 = ev[0];
#pragma unroll
            for (int e = 1; e < 8; ++e) if (ev[e] > v0) { v0 = ev[e]; i0 = e; }
            int i1 = -1; float v1 = -INFINITY;
#pragma unroll
            for (int e = 0; e < 8; ++e) if (e != i0 && ev[e] > v1) { v1 = ev[e]; i1 = e; }
            const float e1 = __expf(v1 - v0), den = 1.f / (1.f + e1);
            rr_e[2 * row] = grp * 8 + i0; rr_e[2 * row + 1] = grp * 8 + i1; rr_w[2 * row] = gprob * den; rr_w[2 * row + 1] = gprob * e1 * den; rr_t[row] = 64 * slab + row;
        }
        if (tid >= 64 && tid < 96) lcnt[tid - 64] = 0;
        __syncthreads();
#pragma unroll 2
        for (int rw8 = 0; rw8 < 8; ++rw8) { const int row = 8 * wave + rw8; const size_t t = (size_t)64 * slab + row; const float rstd = rsd[row]; const float* xr = C.out + t * 1024;
#pragma unroll
            for (int i = 0; i < 4; ++i) { const int k = 4 * lane + 256 * i; const f32x4 xv = *(const f32x4*)(xr + k), g = *(const f32x4*)(gmv + k), s = *(const f32x4*)(shv + k);
                u32x2 o; o.x = pk2(xv[0] * rstd * g[0] + s[0], xv[1] * rstd * g[1] + s[1]); o.y = pk2(xv[2] * rstd * g[2] + s[2], xv[3] * rstd * g[3] + s[3]);
                *(u32x2*)(((bf16_t*)(C.ws + WS_H)) + t * 1024 + k) = o; } }
        int my_e = -1, my_lp = 0, my_slot = 0; float my_w = 0.f;
        if (tid < 128 && !(C.flags & 1)) { my_e = rr_e[tid]; my_w = rr_w[tid]; my_slot = 2 * rr_t[tid >> 1] + (tid & 1); my_lp = atomicAdd(&lcnt[my_e], 1); }
        __syncthreads();
        if (tid < 32) { const int n = lcnt[tid]; lbase[tid] = n ? (int)atomicAdd(((unsigned*)(C.ws + WS_CTL)) + CW_CNT + l * 2048 + 64 * tid, (unsigned)n) : 0; }
        __syncthreads();
        if (my_e >= 0) { const size_t o = (size_t)my_e * ECAP + lbase[my_e] + my_lp; ((int*)(C.ws + WS_LIST))[o] = my_slot; ((float*)(C.ws + WS_WL))[o] = my_w; }
    }
    __syncthreads();
    LAS float* scr = (LAS float*)(C.lds + C.wave * 8448);
    constexpr int I_GU = 32 * 16 * 32, I_DN = 32 * 8 * 32;
    for (int it = (C.flags & 2) ? I_GU + I_DN : gw; it < I_GU + I_DN; it += NGW) {
        if (it < I_GU) { const int e = it / 512, q = it % 512, kb = q / 32, nb = q % 32, n0 = 32 * nb;
            const int up = (n0 >> 7) & 1, col = (n0 >> 8) * 128 + (n0 & 127);
            const float* src = C.in[up ? IN_EU : IN_EG] + ((size_t)(l * 32 + e) * 1024 + 64 * kb) * 512;
            transpose_item(src, 512, col, 32, ((bf16_t*)(C.ws + WS_WGU)) + (size_t)e * 1024 * 1024, 1024, n0, 64 * kb, scr, lane);
        } else { const int r = it - I_GU, e = r / 256, q = r % 256, kb = q / 32, nb = q % 32;
            const float* src = C.in[IN_ED] + ((size_t)(l * 32 + e) * 512 + 64 * kb) * 1024;
            transpose_item(src, 1024, 32 * nb, 32, ((bf16_t*)(C.ws + WS_WD)) + (size_t)e * 1024 * 512, 512, 32 * nb, 64 * kb, scr, lane); }
    }
}
constexpr int NPHASE = 22;
#ifndef PHMASK
#define PHMASK 0x7ff
#endif
#define EN(n) ((PHMASK >> (n)) & 1)
#define IN(k) (lo <= (k) && (k) < hi)
#ifndef XBAR_REP
#define XBAR_REP 1
#endif
#define SEAM(k) do { if (IN((k) + 1)) for (int xb_ = 0; xb_ < XBAR_REP; ++xb_) xcd_barrier(bar); } while (0)
#ifndef REP_PRO
#define REP_PRO 1
#define REP_WIN 1
#define REP_MRG 1
#define REP_UP 1
#define REP_DN 1
#define REP_ROW0 1
#endif
template <int L> __device__ __forceinline__ void run_layer(Ctx& C, const int lo, const int hi, const XcdBarrier& bar) {
    const int l = L;
        const int pb = 1 + 10 * l;
        if (EN(1) && IN(pb + 0)) { fresh(C); phase_rows(C, l, (l > 0 ? 1 : 0) | 2); if (l == 0) for (int rep = 1; rep < REP_ROW0; ++rep) phase_rows(C, l, 2); SEAM(pb + 0); }
        if (EN(2) && IN(pb + 1)) { fresh(C);
            WinOrder S; S.A = (const char*)(C.ws + WS_H); S.B = (const char*)(((const bf16_t*)(C.ws + WS_WIN)) + (size_t)l * NP_ * 1024); S.G = C.G; S.c = C.bid;
            EpiP E{C.ws};
            for (int rep = 0; rep < REP_WIN; ++rep) pg8::gemm_phase<EpiP, WinOrder, false>(C.lds, C.tid, 1024, 2048u, 2048u, S, E);
            SEAM(pb + 1);
        }
        if (EN(3) && IN(pb + 2)) { fresh(C); phase_prep(C, l); SEAM(pb + 2); }
        if (EN(4) && IN(pb + 3)) { fresh(C); phase_mixers(C, l); SEAM(pb + 3); }
        if (EN(5) && IN(pb + 4)) { fresh(C); rwkv_finish(C, l); SEAM(pb + 4); }
        if (EN(6) && IN(pb + 5)) { fresh(C);
            MergeOrder S; S.O0 = ((bf16_t*)(C.ws + WS_OA)); S.O1 = ((bf16_t*)(C.ws + WS_OR)); S.O2 = ((bf16_t*)(C.ws + WS_OG)); S.W = ((bf16_t*)(C.ws + WS_WPROJ)) + (size_t)l * 3 * 1024 * 512; S.G = C.G; S.c = C.vcu;
            EpiMerge E{((bf16_t*)(C.ws + WS_GATES)), ((bf16_t*)(C.ws + WS_H))};
            for (int rep = 0; rep < REP_MRG; ++rep) pg8::gemm_phase<EpiMerge, MergeOrder, false>(C.lds, C.tid, 512, 1024u, 1024u, S, E);
            SEAM(pb + 5);
        }
        if (EN(7) && IN(pb + 6)) { fresh(C);
            pg8::DenseOrder S; S.init(((bf16_t*)(C.ws + WS_H)), ((bf16_t*)(C.ws + WS_WOUT)) + (size_t)l * 1024 * 1024, 2048u, 2048u, T_, 1024, C.G, C.bid);
            EpiOut E{l == 0 ? C.in[IN_X] : C.out, C.out, ((float*)(C.ws + WS_MOD)) + (size_t)l * 8 * 6144 + 2048};
            pg8::gemm_phase<EpiOut, pg8::DenseOrder, false>(C.lds, C.tid, 1024, 2048u, 2048u, S, E);
            SEAM(pb + 6);
        }
        if (EN(8) && IN(pb + 7)) { fresh(C); phase_route(C, l); SEAM(pb + 7); }
        if (EN(9) && IN(pb + 8)) { fresh(C);
            moe_build_table(C, l);
            unsigned* done = ((unsigned*)(C.ws + WS_CTL)) + CW_TD + 8192 * l;
            if (!(C.flags & 256)) { MoeOrder S; S.tab = (const LAS int*)(C.lds + LDS_SCHED); S.A = (const char*)((bf16_t*)(C.ws + WS_H)); S.B = (const char*)((bf16_t*)(C.ws + WS_WGU)); S.LIST = ((int*)(C.ws + WS_LIST)); S.WL = ((float*)(C.ws + WS_WL)); S.G = C.G; S.c = C.vcu; S.down = 0; S.done = done;
              EpiHid E{((bf16_t*)(C.ws + WS_HID)), done};
              pg8::gemm_phase<EpiHid, MoeOrder, true>(C.lds, C.tid, 1024, 2048u, 2048u, S, E); }
            if (!(C.flags & 512)) { MoeOrder S; S.tab = (const LAS int*)(C.lds + LDS_SCHED); S.A = (const char*)((bf16_t*)(C.ws + WS_HID)); S.B = (const char*)((bf16_t*)(C.ws + WS_WD)); S.LIST = ((int*)(C.ws + WS_LIST)); S.WL = ((float*)(C.ws + WS_WL)); S.G = C.G; S.c = C.vcu; S.down = 1; S.done = done;
              EpiDown E{((bf16_t*)(C.ws + WS_YS))};
              pg8::gemm_phase<EpiDown, MoeOrder, false>(C.lds, C.tid, 512, 1024u, 1024u, S, E); }
            SEAM(pb + 9);
        }
    }
__global__ void __launch_bounds__(NTHR, 2) hybrid_fwd(Args args) {
    extern __shared__ __attribute__((aligned(16))) unsigned char lds_raw[];
    Ctx C;
    C.in = args.in; C.out = args.out; C.ws = args.ws; C.ws0 = args.ws;
    C.ldsg = lds_raw; C.lds = (LAS unsigned char*)lds_raw;
    C.flags = args.flags; C.tid = threadIdx.x; C.lane = C.tid & 63; C.wave = __builtin_amdgcn_readfirstlane(C.tid >> 6); C.G = gridDim.x; C.bid = blockIdx.x;
    C.vcu = (C.G % 8 == 0) ? (C.bid % 8) * (C.G / 8) + C.bid / 8 : C.bid;
    volatile LAS unsigned* bst = (volatile LAS unsigned*)(C.lds + LDS_CTL);
    if (C.tid < 4) bst[C.tid] = 0u;
    __syncthreads();
    const int lo = args.ph_lo, hi = args.ph_hi;
    const bool multi = (hi - lo) > 1;
    XcdBarrier bar; bar.bar = ((unsigned*)(C.ws + WS_CTL)) + CW_BAR; bar.x = 0; bar.st = bst;
    if (multi) bar = xcd_barrier_post(((unsigned*)(C.ws + WS_CTL)) + CW_BAR, bst);

    if (EN(0) && IN(0)) { fresh(C); for (int rep = 0; rep < REP_PRO; ++rep) phase_prologue(C); SEAM(0); }
    run_layer<0>(C, lo, hi, bar);
    run_layer<1>(C, lo, hi, bar);
    if (IN(21)) { fresh(C); phase_rows(C, 2, 1); }
}

#ifndef N_LAUNCH_MODE
#define N_LAUNCH_MODE 1
#endif
extern "C" void kernel_launch(void* const* d_in, const int* in_sizes, int n_in, void* d_out, int out_size, void* d_ws, size_t ws_size, hipStream_t stream) {
    static int grid = 0;
    if (grid == 0) {
        if (n_in != 36 || out_size != T_ * D_ || ws_size < WS_END) { fprintf(stderr, "kernel_launch: unexpected problem (n_in %d, out %d, ws %zu < %zu)\n", n_in, out_size, ws_size, (size_t)WS_END); grid = -1; return; }
        int dev = 0, cus = 0, per_cu = 0;
        if (hipGetDevice(&dev) != hipSuccess || hipDeviceGetAttribute(&cus, hipDeviceAttributeMultiprocessorCount, dev) != hipSuccess) { grid = -1; return; }
        if (hipFuncSetAttribute((const void*)hybrid_fwd, hipFuncAttributeMaxDynamicSharedMemorySize, LDS_BYTES) != hipSuccess) { fprintf(stderr, "kernel_launch: hipFuncSetAttribute failed\n"); grid = -1; return; }
        if (hipOccupancyMaxActiveBlocksPerMultiprocessor(&per_cu, (const void*)hybrid_fwd, NTHR, LDS_BYTES) != hipSuccess || per_cu < 1) fprintf(stderr, "kernel_launch: occupancy query says %d\n", per_cu);
        (void)hipGetLastError();
        if (cus < 256) { fprintf(stderr, "kernel_launch: needs 256 CUs, device has %d\n", cus); grid = -1; return; }
        grid = 256;
    }
    if (grid < 0) return;
    (void)hipMemsetAsync((char*)d_ws + WS_CTL, 0, CTL_BYTES, stream);
    Args a{};
    for (int i = 0; i < 36; ++i) a.in[i] = (const float*)d_in[i];
    a.out = (float*)d_out; a.ws = (unsigned char*)d_ws;
#if N_LAUNCH_MODE == 1
    a.ph_lo = 0; a.ph_hi = NPHASE;
    hipLaunchKernelGGL(hybrid_fwd, dim3(grid), dim3(NTHR), LDS_BYTES, stream, a);
#else
#ifndef HREP_LIST
#define HREP_LIST 1,1,1,1,1,1,1,1,1,1,1,1,1,1,1,1,1,1,1,1,1,1
#endif
    static const int hrep[NPHASE] = {HREP_LIST};
#ifndef HREP_FLAGS
#define HREP_FLAGS 3
#endif
    for (int p = 0; p < NPHASE; ++p) for (int r = 0; r < hrep[p]; ++r) { a.ph_lo = p; a.ph_hi = p + 1; a.flags = r ? HREP_FLAGS : 0; hipLaunchKernelGGL(hybrid_fwd, dim3(grid), dim3(NTHR), LDS_BYTES, stream, a); }
#endif
}
```
